# Optimizing an MI355X kernel written in HIP

```python
import jax, jax.numpy as jnp
from jax import lax
import numpy as np

D_MODEL = 1024
BATCH = 8
SEQ = 4096
DEPTH = 1

GRID_W = 64
CTX_LEN = 256
D_MIX = D_MODEL
D_ATTN = D_MIX // 2
D_POOL = D_MIX - D_ATTN
MLA_HEADS = 4
QK_NOPE_DIM = 128
QK_ROPE_DIM = 64
QK_HEAD_DIM = QK_NOPE_DIM + QK_ROPE_DIM
V_HEAD_DIM = D_ATTN // MLA_HEADS
Q_LORA_RANK = 256
KV_LORA_RANK = 128
ROPE_AXIS_DIM = QK_ROPE_DIM // 2
ROPE_BASE = 10000.0
POOL_WINDOWS = (2, 4, 8, 16)
POOL_GROUPS = len(POOL_WINDOWS)
POOL_GROUP_DIM = D_POOL // POOL_GROUPS
Q_BLOCK = 128
NORM_EPS = 1e-6

OFF_CQ = 0
OFF_CKV = OFF_CQ + Q_LORA_RANK
OFF_KR = OFF_CKV + KV_LORA_RANK
OFF_GA = OFF_KR + QK_ROPE_DIM
OFF_PIN = OFF_GA + D_ATTN
OFF_GP = OFF_PIN + D_POOL
D_IN_PROJ = OFF_GP + D_POOL

kernel_name = "hymba_mla_pool_adaln_prefix"


def _rms(x, g):
    xf = x.astype(jnp.float32)
    y = xf * lax.rsqrt(jnp.mean(xf * xf, axis=-1, keepdims=True) + NORM_EPS)
    return (y * g.astype(jnp.float32)).astype(x.dtype)


def _rotate_half(x):
    x1, x2 = jnp.split(x, 2, axis=-1)
    return jnp.concatenate([-x2, x1], axis=-1)


def _axial_rope_tables(L):
    rows = L // GRID_W
    row = jnp.repeat(jnp.arange(rows, dtype=jnp.float32), GRID_W)
    col = jnp.tile(jnp.arange(GRID_W, dtype=jnp.float32), rows)
    n_freq = ROPE_AXIS_DIM // 2
    inv = ROPE_BASE ** (-jnp.arange(n_freq, dtype=jnp.float32) / n_freq)
    ang_r = row[:, None] * inv
    ang_c = col[:, None] * inv
    ang = jnp.concatenate([ang_r, ang_r, ang_c, ang_c], axis=-1)
    return jnp.cos(ang), jnp.sin(ang)


def _apply_axial_rope(x, cos, sin):
    xr, xc = jnp.split(x, 2, axis=-1)
    rot = jnp.concatenate([_rotate_half(xr), _rotate_half(xc)], axis=-1)
    c = cos[:, None, :]
    s = sin[:, None, :]
    return (x.astype(jnp.float32) * c + rot.astype(jnp.float32) * s).astype(x.dtype)


def _mla_qkv(u, q_lora_g, w_uq, kv_lora_g, w_ukv, q_norm_g, k_norm_g, rope):
    B, L = u.shape[0], u.shape[1]
    cq = u[..., OFF_CQ:OFF_CKV]
    ckv = u[..., OFF_CKV:OFF_KR]
    k_rope = u[..., OFF_KR:OFF_GA]
    q = (_rms(cq, q_lora_g) @ w_uq).reshape(B, L, MLA_HEADS, QK_HEAD_DIM)
    kv = (_rms(ckv, kv_lora_g) @ w_ukv).reshape(B, L, MLA_HEADS, QK_NOPE_DIM + V_HEAD_DIM)
    k_nope, v = kv[..., :QK_NOPE_DIM], kv[..., QK_NOPE_DIM:]
    k = jnp.concatenate(
        [k_nope, jnp.broadcast_to(k_rope[:, :, None, :], (B, L, MLA_HEADS, QK_ROPE_DIM))], axis=-1)
    q = _rms(q, q_norm_g)
    k = _rms(k, k_norm_g)
    if rope is not None:
        cos, sin = rope
        q = jnp.concatenate([q[..., :QK_NOPE_DIM], _apply_axial_rope(q[..., QK_NOPE_DIM:], cos, sin)], axis=-1)
        k = jnp.concatenate([k[..., :QK_NOPE_DIM], _apply_axial_rope(k[..., QK_NOPE_DIM:], cos, sin)], axis=-1)
    tr = lambda t: jnp.transpose(t, (0, 2, 1, 3))
    return tr(q), tr(k), tr(v)


def _attend(q, k, v):
    B, H, Lq, dk = q.shape
    nb = Lq // Q_BLOCK
    scale = QK_HEAD_DIM ** -0.5
    qb = jnp.transpose(q.reshape(B, H, nb, Q_BLOCK, dk), (2, 0, 1, 3, 4))

    def one(qblk):
        s = jnp.einsum('bhqd,bhkd->bhqk', qblk, k).astype(jnp.float32) * scale
        p = jax.nn.softmax(s, axis=-1)
        return jnp.einsum('bhqk,bhkd->bhqd', p.astype(v.dtype), v)

    o = lax.map(one, qb)
    o = jnp.transpose(o, (1, 3, 0, 2, 4)).reshape(B, Lq, H * v.shape[-1])
    return o


def _multiscale_pool(u, w_pool, pool_scale):
    B, L, _ = u.shape
    ug = u.reshape(B, L, POOL_GROUPS, POOL_GROUP_DIM)
    cs = jnp.concatenate(
        [jnp.zeros((B, 1, POOL_GROUPS, POOL_GROUP_DIM), jnp.float32),
         jnp.cumsum(ug.astype(jnp.float32), axis=1)], axis=1)
    t = jnp.arange(L, dtype=jnp.int32)[:, None]
    w = jnp.array(POOL_WINDOWS, dtype=jnp.int32)[None, :]
    lo = jnp.clip(t - w // 2, 0, L)
    hi = jnp.clip(t - w // 2 + w, 0, L)
    g = jnp.arange(POOL_GROUPS, dtype=jnp.int32)[None, :]
    win_sum = cs[:, hi, g, :] - cs[:, lo, g, :]
    cnt = (hi - lo).astype(jnp.float32)[None, :, :, None]
    pooled = (win_sum / cnt - ug.astype(jnp.float32)).astype(u.dtype)
    y = jnp.einsum('blgc,gcd->blgd', pooled, w_pool).reshape(B, L, D_POOL)
    return y * pool_scale


def _branches(u, mla_out, w_pool, pool_scale):
    gate_a = u[..., OFF_GA:OFF_PIN]
    pool_in = u[..., OFF_PIN:OFF_GP]
    gate_p = u[..., OFF_GP:D_IN_PROJ]
    br_a = jax.nn.silu(gate_a) * mla_out
    br_p = jax.nn.silu(gate_p) * _multiscale_pool(pool_in, w_pool, pool_scale)
    return jnp.concatenate([br_a, br_p], axis=-1)


def setup_inputs(seed: int = 0) -> dict:
    key = jax.random.key(seed)
    ks = jax.random.split(key, 20)
    f32 = jnp.float32
    nrm = lambda k, shape, s: jax.random.normal(k, shape, f32) * s
    return {
        "x": nrm(ks[0], (BATCH, SEQ, D_MODEL), 1.0),
        "c": nrm(ks[1], (BATCH, D_MODEL), 1.0),
        "ctx": nrm(ks[2], (BATCH, CTX_LEN, D_MODEL), 1.0),
        "c_ctx": nrm(ks[3], (D_MODEL,), 1.0),
        "w_mod": nrm(ks[4], (DEPTH, D_MODEL, 3 * D_MODEL), 0.5 * D_MODEL ** -0.5),
        "b_mod": nrm(ks[5], (DEPTH, 3 * D_MODEL), 0.02),
        "norm_g": 1.0 + nrm(ks[6], (DEPTH, D_MODEL), 0.1),
        "w_in": nrm(ks[7], (DEPTH, D_MODEL, D_IN_PROJ), D_MODEL ** -0.5),
        "q_lora_g": 1.0 + nrm(ks[8], (DEPTH, Q_LORA_RANK), 0.1),
        "w_uq": nrm(ks[9], (DEPTH, Q_LORA_RANK, MLA_HEADS * QK_HEAD_DIM), Q_LORA_RANK ** -0.5),
        "kv_lora_g": 1.0 + nrm(ks[10], (DEPTH, KV_LORA_RANK), 0.1),
        "w_ukv": nrm(ks[11], (DEPTH, KV_LORA_RANK, MLA_HEADS * (QK_NOPE_DIM + V_HEAD_DIM)), KV_LORA_RANK ** -0.5),
        "q_norm_g": 1.0 + nrm(ks[12], (DEPTH, QK_HEAD_DIM), 0.1),
        "k_norm_g": 1.0 + nrm(ks[13], (DEPTH, QK_HEAD_DIM), 0.1),
        "w_pool": nrm(ks[14], (DEPTH, POOL_GROUPS, POOL_GROUP_DIM, POOL_GROUP_DIM), POOL_GROUP_DIM ** -0.5),
        "pool_scale": 1.0 + nrm(ks[15], (DEPTH, D_POOL), 0.1),
        "w_out": nrm(ks[16], (DEPTH, D_MIX, D_MODEL), D_MIX ** -0.5),
    }


def reference(x, c, ctx, c_ctx, w_mod, b_mod, norm_g, w_in, q_lora_g, w_uq, kv_lora_g, w_ukv,
              q_norm_g, k_norm_g, w_pool, pool_scale, w_out):
    L = x.shape[1]
    rope = _axial_rope_tables(L)
    for l in range(DEPTH):
        mod = jax.nn.silu(c) @ w_mod[l] + b_mod[l]
        shift, scale, gate = jnp.split(mod, 3, axis=-1)
        mod_c = jax.nn.silu(c_ctx) @ w_mod[l] + b_mod[l]
        shift_c, scale_c, gate_c = jnp.split(mod_c, 3, axis=-1)

        h = _rms(x, norm_g[l]) * (1.0 + scale[:, None, :]) + shift[:, None, :]
        hc = _rms(ctx, norm_g[l]) * (1.0 + scale_c) + shift_c
        u = h @ w_in[l]
        uc = hc @ w_in[l]

        q, k, v = _mla_qkv(u, q_lora_g[l], w_uq[l], kv_lora_g[l], w_ukv[l],
                           q_norm_g[l], k_norm_g[l], rope)
        qc, kc, vc = _mla_qkv(uc, q_lora_g[l], w_uq[l], kv_lora_g[l], w_ukv[l],
                              q_norm_g[l], k_norm_g[l], None)
        k_all = jnp.concatenate([kc, k], axis=2)
        v_all = jnp.concatenate([vc, v], axis=2)
        attn = _attend(q, k_all, v_all)
        y = _branches(u, attn, w_pool[l], pool_scale[l]) @ w_out[l]
        x_new = x + gate[:, None, :] * y

        if l < DEPTH - 1:
            attn_c = _attend(qc, kc, vc)
            yc = _branches(uc, attn_c, w_pool[l], pool_scale[l]) @ w_out[l]
            ctx = ctx + gate_c * yc
        x = x_new
    return x
```

```cpp
#include <hip/hip_runtime.h>
#include <hip/hip_cooperative_groups.h>
#include <cstdio>
#include <cstdint>
namespace cg = cooperative_groups;

#define LAS __attribute__((address_space(3)))
typedef unsigned short bf16_t;
typedef short bf16x8 __attribute__((ext_vector_type(8)));
typedef short s16x4 __attribute__((ext_vector_type(4)));
typedef float f32x4 __attribute__((ext_vector_type(4)));
typedef float f32x16 __attribute__((ext_vector_type(16)));
typedef unsigned u32x4 __attribute__((ext_vector_type(4)));

constexpr int NB = 8, SEQ = 4096, DM = 1024, CL = 256, LK = SEQ + CL;
constexpr int MT = NB * LK;
constexpr int ML = NB * SEQ;
constexpr int NINP = 2048;
constexpr int OFF_CKV = 256, OFF_KR = 384, OFF_GA = 448, OFF_PIN = 960, OFF_GP = 1472;
constexpr int NH = 4, DQK = 192, DV = 128;
constexpr float EPS = 1e-6f;
constexpr int NTILE = LK / 64;
constexpr int KIMG_B = 64 * DQK * 2;

constexpr size_t al256(size_t x) { return (x + 255) / 256 * 256; }
constexpr size_t WS_BAR = 0;
constexpr size_t WS_MOD = 16384;
constexpr size_t WS_ROPE = WS_MOD + al256(9 * 3072 * 4);
constexpr size_t WS_SSQ = WS_ROPE + al256(2 * 1024 * 4);
constexpr size_t WS_SSKV = WS_SSQ + al256((size_t)MT * 16);
constexpr size_t WS_SSKR = WS_SSKV + al256((size_t)MT * 16);
constexpr size_t WS_WIN = WS_SSKR + al256((size_t)MT * 16);
constexpr size_t WS_WUQ = WS_WIN + al256((size_t)NINP * 1024 * 2);
constexpr size_t WS_WUKV = WS_WUQ + al256((size_t)768 * 256 * 2);
constexpr size_t WS_WP = WS_WUKV + al256((size_t)1024 * 128 * 2);
constexpr size_t WS_WOUT = WS_WP + al256((size_t)2 * 256 * 256 * 2);
constexpr size_t WS_H = WS_WOUT + al256((size_t)1024 * 1024 * 2);
constexpr size_t WS_U = WS_H + al256((size_t)MT * 1024 * 2);
constexpr size_t WS_QRAW = WS_U + al256((size_t)MT * NINP * 2);
constexpr size_t WS_KN = WS_QRAW + al256((size_t)MT * 768 * 2);
constexpr size_t WS_V = WS_KN + al256((size_t)MT * NH * 128 * 2);
constexpr size_t WS_KIMG = WS_V + al256((size_t)MT * NH * 128 * 2);
constexpr size_t WS_POOLED = WS_KIMG + al256((size_t)NB * NH * NTILE * KIMG_B);
constexpr size_t WS_END0 = WS_POOLED + al256((size_t)ML * 512 * 2);
constexpr size_t WS_BR = WS_H;
constexpr size_t WS_END = WS_END0;

struct Params {
    const float *x, *c, *ctx, *c_ctx, *w_mod, *b_mod, *norm_g, *w_in, *q_lora_g, *w_uq, *kv_lora_g, *w_ukv, *q_norm_g, *k_norm_g, *w_pool, *pool_scale, *w_out;
    float* out; unsigned char* ws;
};

__device__ __forceinline__ unsigned cvtpk(float lo, float hi) { unsigned r; asm volatile("v_cvt_pk_bf16_f32 %0, %1, %2" : "=v"(r) : "v"(lo), "v"(hi)); return r; }
__device__ __forceinline__ float bf2f(unsigned short u) { return __uint_as_float(((unsigned)u) << 16); }
__device__ __forceinline__ float bflo(unsigned w) { return __uint_as_float(w << 16); }
__device__ __forceinline__ float bfhi(unsigned w) { return __uint_as_float(w & 0xffff0000u); }
__device__ __forceinline__ unsigned short f2bf(float f) { unsigned u = __float_as_uint(f); u += 0x7FFFu + ((u >> 16) & 1u); return (unsigned short)(u >> 16); }
__device__ __forceinline__ int fresh_tid(int w) {
    int l; asm volatile("v_mbcnt_lo_u32_b32 %0, -1, 0\n\tv_mbcnt_hi_u32_b32 %0, -1, %0" : "=v"(l));
    return (w << 6) | l; }
__device__ __forceinline__ float silu_f(float v) { return v * __builtin_amdgcn_rcpf(1.f + __expf(-v)); }
__device__ __forceinline__ void unpack8(u32x4 w, float* o) { o[0] = bflo(w.x); o[1] = bfhi(w.x); o[2] = bflo(w.y); o[3] = bfhi(w.y); o[4] = bflo(w.z); o[5] = bfhi(w.z); o[6] = bflo(w.w); o[7] = bfhi(w.w); }
__device__ __forceinline__ u32x4 pack8(const float* v) { u32x4 w; w.x = cvtpk(v[0], v[1]); w.y = cvtpk(v[2], v[3]); w.z = cvtpk(v[4], v[5]); w.w = cvtpk(v[6], v[7]); return w; }

namespace pg8 {
constexpr int BM = 256, BK = 64, HALF = 128, HTB = HALF * BK * 2, STAGE_BYTES = 8 * HTB, NXCD = 8, WGM = 8;
__device__ __forceinline__ int lds_byte(int r, int c) { const int st = (r >> 4) * 2 + (c >> 5), rr = r & 15, cc = c & 31, ob = rr * 64 + cc * 2; return st * 1024 + (ob ^ (((ob >> 9) & 1) << 5)); }
__device__ __forceinline__ void stage_rc(int b, int& R, int& C) { const int st = b / 1024, sb = b % 1024, swz = sb ^ (((sb >> 9) & 1) << 5); R = (st >> 1) * 16 + swz / 64; C = (st & 1) * 32 + (swz % 64) / 2; }
__device__ __forceinline__ int perm32(int rho) { const int n = rho >> 4, i = rho & 15; return 8 * (i >> 2) + 4 * n + (i & 3); }
struct Unit { int pm, pn; };
struct Gemm { const bf16_t* A; const bf16_t* Bt; int lda, ldb, K; };
struct StaticOrder {
    int nM, nN, nwg, G, c;
    __device__ void init(int nM_, int nN_, int G_, int c_) { nM = nM_; nN = nN_; nwg = nM * nN; G = G_; c = c_; }
    __device__ bool next(int i, Unit& u) const {
        const long L = (long)i * G + c; if (L >= nwg) return false;
        int wgid = (int)L; { const int q = nwg / NXCD, r = nwg % NXCD, xcd = wgid % NXCD, off = wgid / NXCD; wgid = (xcd < r ? xcd * (q + 1) : r * (q + 1) + (xcd - r) * q) + off; }
        const int nig = WGM * nN, gid = wgid / nig, fm = gid * WGM, gsz = (nM - fm) < WGM ? (nM - fm) : WGM;
        u.pm = fm + ((wgid % nig) % gsz); u.pn = (wgid % nig) / gsz;
        if (latent) u.pm = (u.pm >> 4) * 17 + 1 + (u.pm & 15);
        return true;
    }
    int latent = 0;
};
template <class Epi, class Sched>
__device__ __forceinline__ void gemm_phase(LAS unsigned char* lds, const Gemm g, const Sched& S, const Epi& E, int wv) {
    const int tid = fresh_tid(wv), wid = __builtin_amdgcn_readfirstlane(tid >> 6), lane = tid & 63, wr = wid >> 2, wc = wid & 3, fr = lane & 15, fq = lane >> 4;
    const int K = g.K, nt = K / BK;
    unsigned voffA[2], voffB[2];
#pragma unroll
    for (int i = 0; i < 2; ++i) { int R, C; stage_rc(tid * 16 + i * 8192, R, C); const int Rb = Epi::PERM ? ((R & ~31) + perm32(R & 31)) : R;
        voffA[i] = (unsigned)(R * g.lda + C) * 2u; voffB[i] = (unsigned)(Rb * g.ldb + C) * 2u; }
    const size_t kstep = (size_t)(BK * 2);
    const size_t hstepA = (size_t)HALF * g.lda * 2, hstepB = (size_t)HALF * g.ldb * 2;
    const size_t tstepA = 2 * hstepA, tstepB = 2 * hstepB;
    const unsigned ldsw = (unsigned)wid * 1024u;
    const int aoff = lds_byte(wr * 64 + fr, fq * 8), boff = lds_byte(wc * 32 + fr, fq * 8);
#define PG8_SA(b, h) (((b) * 2 + (h)) * HTB)
#define PG8_SB(b, h) ((4 + (b) * 2 + (h)) * HTB)
#define PG8_STAGE(bufoff, gbase, voff) do { _Pragma("unroll") for (int _i = 0; _i < 2; ++_i) \
        __builtin_amdgcn_global_load_lds((const unsigned*)((const char*)(gbase) + (voff)[_i]), (LAS unsigned*)(lds + (bufoff) + ldsw + _i * 8192), 16, 0, 0); } while (0)
#define PG8_LDA(dst, b, h) do { _Pragma("unroll") for (int m = 0; m < 4; ++m) _Pragma("unroll") for (int k = 0; k < 2; ++k) dst[m][k] = *(const LAS bf16x8*)(lds + PG8_SA(b, h) + aoff + m * 2048 + k * 1024); } while (0)
#define PG8_LDB(dst, b, h) do { _Pragma("unroll") for (int n = 0; n < 2; ++n) _Pragma("unroll") for (int k = 0; k < 2; ++k) dst[n][k] = *(const LAS bf16x8*)(lds + PG8_SB(b, h) + boff + n * 2048 + k * 1024); } while (0)
#define PG8_MMA(ai, bj, At, Bt) do { __builtin_amdgcn_s_setprio(1); _Pragma("unroll") for (int m = 0; m < 4; ++m) _Pragma("unroll") for (int n = 0; n < 2; ++n) _Pragma("unroll") for (int k = 0; k < 2; ++k) \
        acc[ai][bj][m][n] = __builtin_amdgcn_mfma_f32_16x16x32_bf16(Bt[n][k], At[m][k], acc[ai][bj][m][n], 0, 0, 0); __builtin_amdgcn_s_setprio(0); } while (0)
#define PG8_WAIT_V(n) asm volatile("s_waitcnt vmcnt(" #n ")" ::: "memory")
#define PG8_WAIT_L(n) asm volatile("s_waitcnt lgkmcnt(" #n ")" ::: "memory")
#define PG8_BAR __builtin_amdgcn_s_barrier()
#define PG8_SCHED __builtin_amdgcn_sched_barrier(0)
    Unit cur, nxt; int ui = 0;
    if (!S.next(0, cur)) return;
    f32x4 acc[2][2][4][2];
#pragma unroll
    for (int a = 0; a < 2; ++a)
#pragma unroll
        for (int b = 0; b < 2; ++b)
#pragma unroll
            for (int m = 0; m < 4; ++m)
#pragma unroll
                for (int n = 0; n < 2; ++n) acc[a][b][m][n] = (f32x4){0.f, 0.f, 0.f, 0.f};
    bf16x8 At[4][2], B0[2][2], B1[2][2];
    const char* cA = (const char*)g.A + (size_t)cur.pm * tstepA; const char* cB = (const char*)g.Bt + (size_t)cur.pn * tstepB;
    PG8_STAGE(PG8_SB(0, 0), cB, voffB); PG8_STAGE(PG8_SA(0, 0), cA, voffA); PG8_STAGE(PG8_SB(0, 1), cB + hstepB, voffB); PG8_STAGE(PG8_SA(0, 1), cA + hstepA, voffA);
    if (wr == 1) PG8_BAR;
    PG8_WAIT_V(4); PG8_BAR;
    PG8_STAGE(PG8_SB(1, 0), cB + kstep, voffB); PG8_STAGE(PG8_SA(1, 0), cA + kstep, voffA); PG8_STAGE(PG8_SB(1, 1), cB + hstepB + kstep, voffB);
    PG8_WAIT_V(6); PG8_BAR;
    for (;;) {
        const bool has_next = S.next(ui + 1, nxt);
        const char* nA = has_next ? (const char*)g.A + (size_t)nxt.pm * tstepA : cA; const char* nB = has_next ? (const char*)g.Bt + (size_t)nxt.pn * tstepB : cB;
        for (int t = 0; t < nt; t += 2) {
            const bool last = (t == nt - 2);
            const char* a1 = cA + (size_t)(t + 1) * kstep;
            const char* a2 = last ? nA : cA + (size_t)(t + 2) * kstep; const char* b2 = last ? nB : cB + (size_t)(t + 2) * kstep;
            const char* a3 = a2 + kstep; const char* b3 = b2 + kstep;
            PG8_LDB(B0, 0, 0); PG8_SCHED; PG8_LDA(At, 0, 0); PG8_STAGE(PG8_SA(1, 1), a1 + hstepA, voffA);
            PG8_WAIT_L(8); PG8_BAR; PG8_WAIT_L(0); PG8_MMA(0, 0, At, B0); PG8_BAR; PG8_SCHED;
            PG8_LDB(B1, 0, 1); PG8_STAGE(PG8_SB(0, 0), b2, voffB);
            PG8_BAR; PG8_WAIT_L(0); PG8_MMA(0, 1, At, B1); PG8_BAR;
            PG8_LDA(At, 0, 1); PG8_STAGE(PG8_SA(0, 0), a2, voffA);
            PG8_BAR; PG8_WAIT_L(0); PG8_MMA(1, 0, At, B0); PG8_BAR; PG8_SCHED;
            PG8_STAGE(PG8_SB(0, 1), b2 + hstepB, voffB);
            PG8_WAIT_V(6); PG8_BAR; PG8_MMA(1, 1, At, B1); PG8_BAR;
            PG8_LDB(B0, 1, 0); PG8_SCHED; PG8_LDA(At, 1, 0); PG8_STAGE(PG8_SA(0, 1), a2 + hstepA, voffA);
            PG8_WAIT_L(8); PG8_BAR; PG8_WAIT_L(0); PG8_MMA(0, 0, At, B0); PG8_BAR; PG8_SCHED;
            PG8_LDB(B1, 1, 1); PG8_STAGE(PG8_SB(1, 0), b3, voffB);
            PG8_BAR; PG8_WAIT_L(0); PG8_MMA(0, 1, At, B1); PG8_BAR;
            PG8_LDA(At, 1, 1); PG8_STAGE(PG8_SA(1, 0), a3, voffA);
            PG8_BAR; PG8_WAIT_L(0); PG8_MMA(1, 0, At, B0); PG8_BAR; PG8_SCHED;
            PG8_STAGE(PG8_SB(1, 1), b3 + hstepB, voffB);
            PG8_WAIT_V(6); PG8_BAR; PG8_MMA(1, 1, At, B1); PG8_BAR;
        }
        { int l2; asm volatile("v_mbcnt_lo_u32_b32 %0, -1, 0\n\tv_mbcnt_hi_u32_b32 %0, -1, %0" : "=v"(l2));
          E(acc, cur, wr, wc, l2 & 15, l2 >> 4); }
        if (!has_next) break;
#pragma unroll
        for (int a = 0; a < 2; ++a)
#pragma unroll
            for (int b = 0; b < 2; ++b)
#pragma unroll
                for (int m = 0; m < 4; ++m)
#pragma unroll
                    for (int n = 0; n < 2; ++n) acc[a][b][m][n] = (f32x4){0.f, 0.f, 0.f, 0.f};
        cur = nxt; cA = nA; cB = nB; ++ui;
    }
    PG8_WAIT_V(0);
    if (wr == 0) PG8_BAR;
    PG8_BAR;
#undef PG8_SA
#undef PG8_SB
#undef PG8_STAGE
#undef PG8_LDA
#undef PG8_LDB
#undef PG8_MMA
#undef PG8_WAIT_V
#undef PG8_WAIT_L
#undef PG8_BAR
#undef PG8_SCHED
}

struct EpiStore {
    static constexpr bool PERM = true;
    bf16_t* O; int ldc;
    __device__ __forceinline__ void operator()(const f32x4 (&acc)[2][2][4][2], const Unit& u, int wr, int wc, int fr, int fq) const {
        const int row0 = u.pm * BM + wr * 64 + fr, col0 = u.pn * BM + wc * 32 + 8 * fq;
#pragma unroll
        for (int ai = 0; ai < 2; ++ai)
#pragma unroll
            for (int m = 0; m < 4; ++m) { bf16_t* rowp = O + (size_t)(row0 + ai * HALF + m * 16) * ldc + col0;
#pragma unroll
                for (int bj = 0; bj < 2; ++bj) { const f32x4 v0 = acc[ai][bj][m][0], v1 = acc[ai][bj][m][1];
                    u32x4 w; w.x = cvtpk(v0[0], v0[1]); w.y = cvtpk(v0[2], v0[3]); w.z = cvtpk(v1[0], v1[1]); w.w = cvtpk(v1[2], v1[3]);
                    *(u32x4*)(rowp + bj * HALF) = w; } }
    }
};
struct EpiU {
    static constexpr bool PERM = true;
    bf16_t* U; float* SSQ; float* SSKV; float* SSKR;
    __device__ __forceinline__ void operator()(const f32x4 (&acc)[2][2][4][2], const Unit& u, int wr, int wc, int fr, int fq) const {
        const int row0 = u.pm * BM + wr * 64 + fr, col0 = u.pn * BM + wc * 32 + 8 * fq;
#pragma unroll
        for (int ai = 0; ai < 2; ++ai)
#pragma unroll
            for (int m = 0; m < 4; ++m) { const int row = row0 + ai * HALF + m * 16; bf16_t* rowp = U + (size_t)row * NINP + col0; float ss[2];
#pragma unroll
                for (int bj = 0; bj < 2; ++bj) { const f32x4 v0 = acc[ai][bj][m][0], v1 = acc[ai][bj][m][1];
                    u32x4 w; w.x = cvtpk(v0[0], v0[1]); w.y = cvtpk(v0[2], v0[3]); w.z = cvtpk(v1[0], v1[1]); w.w = cvtpk(v1[2], v1[3]);
                    *(u32x4*)(rowp + bj * HALF) = w;
                    ss[bj] = v0[0] * v0[0] + v0[1] * v0[1] + v0[2] * v0[2] + v0[3] * v0[3] + v1[0] * v1[0] + v1[1] * v1[1] + v1[2] * v1[2] + v1[3] * v1[3]; }
                if (u.pn <= 1) {
                    float s0 = ss[0], s1 = ss[1];
                    s0 += __shfl_xor(s0, 16); s0 += __shfl_xor(s0, 32); s1 += __shfl_xor(s1, 16); s1 += __shfl_xor(s1, 32);
                    if (fq == 0) {
                        if (u.pn == 0) SSQ[(size_t)row * 4 + wc] = s0 + s1;
                        else { SSKV[(size_t)row * 4 + wc] = s0; if (wc < 2) SSKR[(size_t)row * 4 + wc] = s1; }
                    }
                }
            }
    }
};
struct EpiKV {
    static constexpr bool PERM = true;
    char* KIMG; bf16_t* V; const bf16_t* U; const float* SSKV; const float* SSKR; const float* kg; const float* ROPEC; LAS float* part;
    __device__ __forceinline__ void operator()(const f32x4 (&acc)[2][2][4][2], const Unit& u, int wr, int wc, int fr, int fq) const {
        const int row0 = u.pm * BM + wr * 64 + fr, col0 = wc * 32 + 8 * fq, h = u.pn;
        const int b = (u.pm * BM) / LK; const int jbase = u.pm * BM - b * LK; const bool lat = jbase != 0;
        LAS float* mine = part + (wr * 4 + wc) * 128;
        float rs[8];
#pragma unroll
        for (int ai = 0; ai < 2; ++ai) {
            f32x4 s4[4]; float kr2[4];
#pragma unroll
            for (int m = 0; m < 4; ++m) { const size_t ro = (size_t)(row0 + ai * HALF + m * 16) * 4; s4[m] = *(const f32x4*)(SSKV + ro); const float2 t = *(const float2*)(SSKR + ro); kr2[m] = t.x + t.y; }
#pragma unroll
            for (int m = 0; m < 4; ++m) { const f32x4 q4 = s4[m]; const float r1 = rsqrtf((q4[0] + q4[1] + q4[2] + q4[3]) * (1.f / 128.f) + EPS); rs[ai * 4 + m] = r1;
                const f32x4 v0 = acc[ai][0][m][0], v1 = acc[ai][0][m][1];
                float ss = v0[0] * v0[0] + v0[1] * v0[1] + v0[2] * v0[2] + v0[3] * v0[3] + v1[0] * v1[0] + v1[1] * v1[1] + v1[2] * v1[2] + v1[3] * v1[3];
                ss *= r1 * r1;
                ss += __shfl_xor(ss, 16); ss += __shfl_xor(ss, 32);
                if (wc == 0) ss += kr2[m];
                if (fq == 0) mine[(ai * 4 + m) * 16 + fr] = ss; } }
        asm volatile("s_waitcnt lgkmcnt(0)" ::: "memory"); __builtin_amdgcn_s_barrier(); asm volatile("" ::: "memory");
        float rk[8];
#pragma unroll
        for (int i8 = 0; i8 < 8; ++i8) { const int o = i8 * 16 + fr; LAS float* pr = part + wr * 4 * 128;
            rk[i8] = rsqrtf((pr[o] + pr[128 + o] + pr[256 + o] + pr[384 + o]) * (1.f / 192.f) + EPS); }
        const int cn = 4 * wc + fq; const f32x4 gn0 = *(const f32x4*)(kg + cn * 8), gn1 = *(const f32x4*)(kg + cn * 8 + 4);
        const int cr = (4 * wc + fq) & 7, q = fq; const bool first = q < 2; const int cp = first ? cr + 2 : cr - 2;
        const f32x4 ga0 = *(const f32x4*)(kg + 128 + cr * 8), ga1 = *(const f32x4*)(kg + 128 + cr * 8 + 4), gb0 = *(const f32x4*)(kg + 128 + cp * 8), gb1 = *(const f32x4*)(kg + 128 + cp * 8 + 4);
        __builtin_amdgcn_sched_barrier(0);
#pragma unroll
        for (int ai = 0; ai < 2; ++ai)
#pragma unroll
            for (int m = 0; m < 4; ++m) { const int i8 = ai * 4 + m; const float rr = rs[i8] * rk[i8];
                const int tile = (jbase >> 6) + ai * 2 + wr, kk = m * 16 + fr, j = jbase + ai * HALF + wr * 64 + kk;
                char* img = KIMG + ((size_t)(b * NH + h) * NTILE + tile) * KIMG_B + ((kk >> 5) * 64 + (kk & 31)) * 16;
                { const f32x4 v0 = acc[ai][0][m][0], v1 = acc[ai][0][m][1]; float o[8];
#pragma unroll
                  for (int e = 0; e < 4; ++e) { o[e] = v0[e] * rr * gn0[e]; o[4 + e] = v1[e] * rr * gn1[e]; }
                  *(u32x4*)(img + ((cn >> 1) * 128 + (cn & 1) * 32) * 16) = pack8(o); }
                { const f32x4 v0 = acc[ai][1][m][0] * rs[i8], v1 = acc[ai][1][m][1] * rs[i8];
                  u32x4 w; w.x = cvtpk(v0[0], v0[1]); w.y = cvtpk(v0[2], v0[3]); w.z = cvtpk(v1[0], v1[1]); w.w = cvtpk(v1[2], v1[3]);
                  *(u32x4*)(V + ((size_t)(b * NH + h) * LK + j) * 128 + col0) = w; } }
        __builtin_amdgcn_sched_barrier(0);
        if (wc < 2) {
#pragma unroll
            for (int pr2 = 0; pr2 < 4; ++pr2) {
                u32x4 xa[2], xb[2]; f32x4 c0[2], c1[2], s0[2], s1[2];
#pragma unroll
                for (int t = 0; t < 2; ++t) { const int i8 = pr2 * 2 + t, ai = i8 >> 2, m = i8 & 3; const int row = row0 + ai * HALF + m * 16;
                    const int kk = m * 16 + fr, j = jbase + ai * HALF + wr * 64 + kk; const int pos = j - CL; const int posi = lat ? (wc == 0 ? (pos >> 6) : (pos & 63)) : 0;
                    const bf16_t* krrow = U + (size_t)row * NINP + OFF_KR;
                    xa[t] = *(const u32x4*)(krrow + cr * 8); xb[t] = *(const u32x4*)(krrow + cp * 8);
                    c0[t] = *(const f32x4*)(ROPEC + posi * 16 + (q & 1) * 8); c1[t] = *(const f32x4*)(ROPEC + posi * 16 + (q & 1) * 8 + 4);
                    s0[t] = *(const f32x4*)(ROPEC + 1024 + posi * 16 + (q & 1) * 8); s1[t] = *(const f32x4*)(ROPEC + 1024 + posi * 16 + (q & 1) * 8 + 4); }
                __builtin_amdgcn_sched_barrier(0);
#pragma unroll
                for (int t = 0; t < 2; ++t) { const int i8 = pr2 * 2 + t, ai = i8 >> 2, m = i8 & 3;
                    const int tile = (jbase >> 6) + ai * 2 + wr, kk = m * 16 + fr;
                    char* img = KIMG + ((size_t)(b * NH + h) * NTILE + tile) * KIMG_B + ((kk >> 5) * 64 + (kk & 31)) * 16;
                    float fa[8], fb[8], o[8]; unpack8(xa[t], fa); unpack8(xb[t], fb);
#pragma unroll
                    for (int e = 0; e < 8; ++e) { const float a = fa[e] * rk[i8] * ((e < 4) ? ga0[e & 3] : ga1[e & 3]), pn = fb[e] * rk[i8] * ((e < 4) ? gb0[e & 3] : gb1[e & 3]);
                        const float cs = lat ? ((e < 4) ? c0[t][e & 3] : c1[t][e & 3]) : 1.f, sn = lat ? ((e < 4) ? s0[t][e & 3] : s1[t][e & 3]) : 0.f;
                        o[e] = first ? (a * cs - pn * sn) : (a * cs + pn * sn); }
                    const int c = 16 + cr; *(u32x4*)(img + ((c >> 1) * 128 + (c & 1) * 32) * 16) = pack8(o); }
                __builtin_amdgcn_sched_barrier(0); }
        }
    }
};
struct EpiOut {
    static constexpr bool PERM = false;
    float* out; const float* x; const float* MOD;
    __device__ __forceinline__ void operator()(const f32x4 (&acc)[2][2][4][2], const Unit& u, int wr, int wc, int fr, int fq) const {
        const int row0 = u.pm * BM + wr * 64 + fr, col0 = u.pn * BM + wc * 32 + 4 * fq;
        const int b = (u.pm * BM) >> 12;
        f32x4 gv[2][2];
#pragma unroll
        for (int bj = 0; bj < 2; ++bj)
#pragma unroll
            for (int n = 0; n < 2; ++n) gv[bj][n] = *(const f32x4*)(MOD + b * 3072 + 2048 + col0 + bj * HALF + n * 16);
#pragma unroll
        for (int ai = 0; ai < 2; ++ai) {
            f32x4 xv[4][2][2];
#pragma unroll
            for (int m = 0; m < 4; ++m) { const size_t ro = (size_t)(row0 + ai * HALF + m * 16) * 1024 + col0;
#pragma unroll
                for (int bj = 0; bj < 2; ++bj)
#pragma unroll
                    for (int n = 0; n < 2; ++n) xv[m][bj][n] = *(const f32x4*)(x + ro + bj * HALF + n * 16); }
            __builtin_amdgcn_sched_barrier(0);
#pragma unroll
            for (int m = 0; m < 4; ++m) { const size_t ro = (size_t)(row0 + ai * HALF + m * 16) * 1024 + col0;
#pragma unroll
                for (int bj = 0; bj < 2; ++bj)
#pragma unroll
                    for (int n = 0; n < 2; ++n) *(f32x4*)(out + ro + bj * HALF + n * 16) = xv[m][bj][n] + gv[bj][n] * acc[ai][bj][m][n]; }
            __builtin_amdgcn_sched_barrier(0); }
    }
};
}

constexpr int NW = 8, QBLK = 32, KVBLK = 64;
constexpr float SCALE = 0.07216878364870323f;
constexpr float THR = 8.f;
constexpr int SDEPTH = 1;
constexpr int SHM_V = KVBLK * DV * 2, SHM_K = KIMG_B, SHM_ATTN = 2 * SHM_V + 2 * SHM_K + NW * 64 * 4;
#define SBAR() __builtin_amdgcn_sched_barrier(0)
__device__ __forceinline__ int crow(int r, int hi) { return (r & 3) + 8 * (r >> 2) + 4 * hi; }

__device__ __forceinline__ void partialSM(f32x16& p0, f32x16& p1, float& m_reg, float& mn, float& alpha) {
    constexpr float C = SCALE * 1.4426950408889634f;
    float pmax = p0[0];
#pragma unroll
    for (int r = 1; r < 16; ++r) pmax = fmaxf(pmax, p0[r]);
#pragma unroll
    for (int r = 0; r < 16; ++r) pmax = fmaxf(pmax, p1[r]);
    { auto rr = __builtin_amdgcn_permlane32_swap(__float_as_uint(pmax), __float_as_uint(pmax), false, false);
      pmax = fmaxf(__uint_as_float(rr[0]), __uint_as_float(rr[1])); }
    if (__builtin_expect(__all(pmax - m_reg <= THR / SCALE), 1)) { mn = m_reg; alpha = 1.f; }
    else { mn = fmaxf(m_reg, pmax); alpha = __builtin_amdgcn_exp2f((m_reg - mn) * C); m_reg = mn; }
    const float mnC = -mn * C;
#pragma unroll
    for (int r = 0; r < 16; ++r) p0[r] = fmaf(p0[r], C, mnC);
#pragma unroll
    for (int r = 0; r < 16; ++r) p1[r] = fmaf(p1[r], C, mnC);
#pragma unroll
    for (int r = 0; r < 16; ++r) p0[r] = __builtin_amdgcn_exp2f(p0[r]);
}
__device__ __forceinline__ void finishSM(f32x16& p0, f32x16& p1, float alpha, float& l_reg, bf16x8& pa0, bf16x8& pa1, bf16x8& pa2, bf16x8& pa3) {
#pragma unroll
    for (int r = 0; r < 16; ++r) p1[r] = __builtin_amdgcn_exp2f(p1[r]);
    float ps = 0;
#pragma unroll
    for (int r = 0; r < 16; ++r) ps += p0[r];
#pragma unroll
    for (int r = 0; r < 16; ++r) ps += p1[r];
    { auto rr = __builtin_amdgcn_permlane32_swap(__float_as_uint(ps), __float_as_uint(ps), false, false);
      ps = __uint_as_float(rr[0]) + __uint_as_float(rr[1]); }
    l_reg = l_reg * alpha + ps;
#define PK4(P, BASE, OUT) do { unsigned a0 = cvtpk(P[BASE + 0], P[BASE + 1]), a1 = cvtpk(P[BASE + 2], P[BASE + 3]);   \
    unsigned b0 = cvtpk(P[BASE + 4], P[BASE + 5]), b1 = cvtpk(P[BASE + 6], P[BASE + 7]);                              \
    auto r0 = __builtin_amdgcn_permlane32_swap(a0, b0, false, false); auto r1 = __builtin_amdgcn_permlane32_swap(a1, b1, false, false); \
    u32x4 w = {r0[0], r1[0], r0[1], r1[1]}; OUT = *reinterpret_cast<bf16x8*>(&w); } while (0)
    PK4(p0, 0, pa0); PK4(p0, 8, pa1); PK4(p1, 0, pa2); PK4(p1, 8, pa3);
#undef PK4
}
__device__ __forceinline__ void qkt(f32x16& p0, f32x16& p1, const char* Ks, const bf16x8* qr, int lane) {
    p0 = f32x16{}; p1 = f32x16{};
#pragma unroll
    for (int d0 = 0; d0 < 12; ++d0) {
        const bf16x8 b0 = *reinterpret_cast<const bf16x8*>(Ks + lane * 16 + d0 * 2048);
        const bf16x8 b1 = *reinterpret_cast<const bf16x8*>(Ks + lane * 16 + d0 * 2048 + 1024);
        p0 = __builtin_amdgcn_mfma_f32_32x32x16_bf16(b0, qr[d0], p0, 0, 0, 0);
        p1 = __builtin_amdgcn_mfma_f32_32x32x16_bf16(b1, qr[d0], p1, 0, 0, 0); }
}
__device__ __forceinline__ int v_st(int k, int c) { const int kk = (k & ~0xC) | ((k & 4) << 1) | ((k & 8) >> 1); return ((kk >> 3) * 4 + (c >> 5)) * 512 + ((kk & 7) * 32 + (c & 31)) * 2; }
__device__ __forceinline__ int v_rd_base(int lane) { return ((lane & 3) << 3) | (((lane >> 2) & 3) << 6) | (((lane >> 4) & 1) << 5) | (((lane >> 5) & 1) << 8); }
constexpr int v_rd_off(int d0, int ks, int half) { return d0 * 512 + ks * 4096 + half * 2048; }
template <int OFF> __device__ __forceinline__ s16x4 tr_read(int vb) {
    s16x4 r; asm volatile("ds_read_b64_tr_b16 %0, %1 offset:%2" : "=&v"(r) : "v"(vb), "i"(OFF) : "memory"); return r;
}
template <int D0> __device__ __forceinline__ void pv_one(f32x16& od, int vb, bf16x8 pa0, bf16x8 pa1, bf16x8 pa2, bf16x8 pa3) {
    const s16x4 l0 = tr_read<v_rd_off(D0, 0, 0)>(vb), h0 = tr_read<v_rd_off(D0, 0, 1)>(vb), l1 = tr_read<v_rd_off(D0, 1, 0)>(vb), h1 = tr_read<v_rd_off(D0, 1, 1)>(vb);
    const s16x4 l2 = tr_read<v_rd_off(D0, 2, 0)>(vb), h2 = tr_read<v_rd_off(D0, 2, 1)>(vb), l3 = tr_read<v_rd_off(D0, 3, 0)>(vb), h3 = tr_read<v_rd_off(D0, 3, 1)>(vb);
    asm volatile("s_waitcnt lgkmcnt(0)" ::: "memory"); SBAR();
#define PK(L, H) (bf16x8){L[0], L[1], L[2], L[3], H[0], H[1], H[2], H[3]}
    od = __builtin_amdgcn_mfma_f32_32x32x16_bf16(pa0, PK(l0, h0), od, 0, 0, 0);
    od = __builtin_amdgcn_mfma_f32_32x32x16_bf16(pa1, PK(l1, h1), od, 0, 0, 0);
    od = __builtin_amdgcn_mfma_f32_32x32x16_bf16(pa2, PK(l2, h2), od, 0, 0, 0);
    od = __builtin_amdgcn_mfma_f32_32x32x16_bf16(pa3, PK(l3, h3), od, 0, 0, 0);
#undef PK
}
__device__ __forceinline__ void pv_d0(f32x16* o, int vb, bf16x8 pa0, bf16x8 pa1, bf16x8 pa2, bf16x8 pa3) {
    pv_one<0>(o[0], vb, pa0, pa1, pa2, pa3); pv_one<1>(o[1], vb, pa0, pa1, pa2, pa3); pv_one<2>(o[2], vb, pa0, pa1, pa2, pa3); pv_one<3>(o[3], vb, pa0, pa1, pa2, pa3);
}

__device__ __forceinline__ void attn_item(const Params& p, int b, int h, int qb, char* lds, int wv) {
    const bf16_t* QRAW = (const bf16_t*)(p.ws + WS_QRAW); const bf16_t* U = (const bf16_t*)(p.ws + WS_U); const float* SSQ = (const float*)(p.ws + WS_SSQ);
    const float* ROPEC = (const float*)(p.ws + WS_ROPE); const float* ROPES = ROPEC + 1024;
    const char* Kimg = (const char*)(p.ws + WS_KIMG) + (size_t)(b * NH + h) * NTILE * KIMG_B;
    const bf16_t* Vh = (const bf16_t*)(p.ws + WS_V) + (size_t)(b * NH + h) * LK * 128;
    bf16_t* BR = (bf16_t*)(p.ws + WS_BR);
    const int tid = fresh_tid(wv), wid = tid >> 6, lane = tid & 63, r32 = lane & 31, hi = lane >> 5;
    char* V_lds = lds; char* K_lds = lds + 2 * SHM_V;
    float* wsl = (float*)(lds + 2 * SHM_V + 2 * SHM_K) + wid * 64; float* li_l = wsl; float* al_l = wsl + 32;
    float m_reg = -1e30f, l_reg = 0; f32x16 o[4] = {}; bf16x8 qr[12];
    const int pos = qb * 256 + wid * QBLK + r32;
    const size_t urow = (size_t)b * LK + CL + pos;
    {
        const bf16_t* qp = QRAW + urow * 768 + h * DQK + hi * 8;
        u32x4 raw[12];
#pragma unroll
        for (int d0 = 0; d0 < 12; ++d0) raw[d0] = *(const u32x4*)(qp + d0 * 16);
        const f32x4 s4 = *(const f32x4*)(SSQ + urow * 4);
        const float rstd_q = rsqrtf((s4[0] + s4[1] + s4[2] + s4[3]) * (1.f / 256.f) + EPS);
        float ss = 0.f;
#pragma unroll
        for (int d0 = 0; d0 < 12; ++d0) { float t[8]; unpack8(raw[d0], t);
#pragma unroll
            for (int e = 0; e < 8; ++e) { const float v = t[e] * rstd_q; ss += v * v; } }
        { auto rr = __builtin_amdgcn_permlane32_swap(__float_as_uint(ss), __float_as_uint(ss), false, false); ss = __uint_as_float(rr[0]) + __uint_as_float(rr[1]); }
        SBAR();
        const float rq = rsqrtf(ss * (1.f / 192.f) + EPS) * rstd_q;
        const int prow = pos >> 6, pcol = pos & 63;
#pragma unroll
        for (int d0 = 0; d0 < 8; ++d0) { float t[8]; unpack8(raw[d0], t);
            const f32x4 g0 = *(const f32x4*)(p.q_norm_g + d0 * 16 + hi * 8), g1 = *(const f32x4*)(p.q_norm_g + d0 * 16 + hi * 8 + 4);
#pragma unroll
            for (int e = 0; e < 4; ++e) { t[e] *= rq * g0[e]; t[4 + e] *= rq * g1[e]; }
            const u32x4 w = pack8(t); qr[d0] = *reinterpret_cast<const bf16x8*>(&w); SBAR(); }
#pragma unroll
        for (int pr = 0; pr < 2; ++pr) { const int da = 8 + 2 * pr, db = da + 1; float ta[8], tb[8]; unpack8(raw[da], ta); unpack8(raw[db], tb);
            const f32x4 ga0 = *(const f32x4*)(p.q_norm_g + da * 16 + hi * 8), ga1 = *(const f32x4*)(p.q_norm_g + da * 16 + hi * 8 + 4);
            const f32x4 gb0 = *(const f32x4*)(p.q_norm_g + db * 16 + hi * 8), gb1 = *(const f32x4*)(p.q_norm_g + db * 16 + hi * 8 + 4);
            const int pp = pr ? pcol : prow;
#pragma unroll
            for (int e = 0; e < 8; ++e) { const float ga = (e < 4) ? ga0[e & 3] : ga1[e & 3], gb = (e < 4) ? gb0[e & 3] : gb1[e & 3];
                const float a = ta[e] * rq * ga, bb = tb[e] * rq * gb; const int fi = hi * 8 + e;
                const float cs = ROPEC[pp * 16 + fi], sn = ROPES[pp * 16 + fi];
                ta[e] = a * cs - bb * sn; tb[e] = bb * cs + a * sn; }
            const u32x4 wa = pack8(ta), wb = pack8(tb); qr[da] = *reinterpret_cast<const bf16x8*>(&wa); qr[db] = *reinterpret_cast<const bf16x8*>(&wb); }
    }
    const int sr = tid >> 4, sc = (tid & 15) * 8, vst0 = v_st(sr, sc), vst1 = v_st(32 + sr, sc);
    const int vb0 = (int)(uintptr_t)V_lds + v_rd_base(lane);
    struct { bf16x8 vs0, vs1, ks0, ks1, ks2; } sr_[SDEPTH];
#define SLOAD(i, t) do { const size_t k0_ = (size_t)(t) * KVBLK; \
    sr_[i].vs0 = *(const bf16x8*)(Vh + (k0_ + sr) * 128 + sc); sr_[i].vs1 = *(const bf16x8*)(Vh + (k0_ + 32 + sr) * 128 + sc); \
    const char* kp_ = Kimg + (size_t)(t) * KIMG_B + tid * 16; \
    sr_[i].ks0 = *(const bf16x8*)(kp_); sr_[i].ks1 = *(const bf16x8*)(kp_ + 8192); sr_[i].ks2 = *(const bf16x8*)(kp_ + 16384); } while (0)
#define SWRITE(bu, i) do { *(bf16x8*)(V_lds + (bu) * SHM_V + vst0) = sr_[i].vs0; *(bf16x8*)(V_lds + (bu) * SHM_V + vst1) = sr_[i].vs1; \
    char* kd_ = K_lds + (bu) * SHM_K + tid * 16; *(bf16x8*)(kd_) = sr_[i].ks0; *(bf16x8*)(kd_ + 8192) = sr_[i].ks1; *(bf16x8*)(kd_ + 16384) = sr_[i].ks2; } while (0)
#define SWAIT() do { if constexpr (SDEPTH == 2) asm volatile("s_waitcnt vmcnt(5)" ::: "memory"); else asm volatile("s_waitcnt vmcnt(0)" ::: "memory"); } while (0)
#define RESC(a) do { if (__any((a) < 1.f)) { if (hi == 0) al_l[r32] = (a); asm volatile("s_waitcnt lgkmcnt(0)" ::: "memory"); \
    _Pragma("unroll") for (int d = 0; d < 4; ++d) _Pragma("unroll") for (int r = 0; r < 16; ++r) o[d][r] *= al_l[crow(r, hi)]; } } while (0)
    f32x16 pA0, pA1, pB0, pB1; float mnA, mnB, alA, alB; bf16x8 pa0, pa1, pa2, pa3; constexpr int NT = NTILE;
    constexpr int SE = 0, SO = SDEPTH - 1;
    SLOAD(SE, 0); asm volatile("s_waitcnt vmcnt(0)" ::: "memory"); SWRITE(0, SE); __syncthreads();
    qkt(pA0, pA1, K_lds, qr, lane); partialSM(pA0, pA1, m_reg, mnA, alA);
    SLOAD(SO, 1); if constexpr (SDEPTH == 2) { SLOAD(SE, 2); }
    SWAIT(); SWRITE(1, SO); __syncthreads();
    for (int j = 1; j + 1 < NT; j += 2) {
        SBAR(); qkt(pB0, pB1, K_lds + SHM_K, qr, lane);
        finishSM(pA0, pA1, alA, l_reg, pa0, pa1, pa2, pa3); SBAR();
        SLOAD(SO, j + SDEPTH); SBAR();
        pv_d0(o, vb0, pa0, pa1, pa2, pa3); partialSM(pB0, pB1, m_reg, mnB, alB);
        __syncthreads(); SWAIT(); SWRITE(0, SE);
        RESC(alB); __syncthreads();
        SBAR(); qkt(pA0, pA1, K_lds, qr, lane);
        finishSM(pB0, pB1, alB, l_reg, pa0, pa1, pa2, pa3); SBAR();
        if (SDEPTH == 1 || j + 3 < NT) SLOAD(SE, j + 1 + SDEPTH); SBAR();
        pv_d0(o, vb0 + SHM_V, pa0, pa1, pa2, pa3); partialSM(pA0, pA1, m_reg, mnA, alA);
        __syncthreads(); SWAIT(); SWRITE(1, SO);
        RESC(alA); __syncthreads();
    }
    SBAR(); qkt(pB0, pB1, K_lds + SHM_K, qr, lane);
    finishSM(pA0, pA1, alA, l_reg, pa0, pa1, pa2, pa3); SBAR();
    pv_d0(o, vb0, pa0, pa1, pa2, pa3); partialSM(pB0, pB1, m_reg, mnB, alB);
    __syncthreads(); RESC(alB);
    finishSM(pB0, pB1, alB, l_reg, pa0, pa1, pa2, pa3); SBAR();
    pv_d0(o, vb0 + SHM_V, pa0, pa1, pa2, pa3);
    if (hi == 0) li_l[r32] = l_reg; asm volatile("s_waitcnt lgkmcnt(0)" ::: "memory");
    float rli[16];
#pragma unroll
    for (int r = 0; r < 16; ++r) rli[r] = __builtin_amdgcn_rcpf(li_l[crow(r, hi)]);
    const int posw = qb * 256 + wid * QBLK;
    unsigned short gts[16][4];
#pragma unroll
    for (int r = 0; r < 16; ++r) { const int qpos = posw + crow(r, hi); const int orow = (qpos & 127) * 32 + (qpos >> 7);
        const bf16_t* gp = U + ((size_t)b * LK + CL + orow) * NINP + OFF_GA + h * 128 + r32;
#pragma unroll
        for (int d0 = 0; d0 < 4; ++d0) gts[r][d0] = gp[d0 * 32]; }
    SBAR();
#pragma unroll
    for (int r = 0; r < 16; ++r) { const int qpos = posw + crow(r, hi);
        const int orow = (qpos & 127) * 32 + (qpos >> 7);
        bf16_t* op = BR + ((size_t)b * SEQ + orow) * 1024 + h * 128 + r32;
#pragma unroll
        for (int d0 = 0; d0 < 4; ++d0) { const float g = bf2f(gts[r][d0]); op[d0 * 32] = f2bf(silu_f(g) * o[d0][r] * rli[r]); } }
#undef SLOAD
#undef SWRITE
#undef SWAIT
#undef RESC
}

__device__ __forceinline__ void phase_mod(const Params& p, char* lds, int wv) {
    float* MOD = (float*)(p.ws + WS_MOD);
    float* sc = (float*)lds;
    float* part = sc + 9 * 1024;
    const int tid = fresh_tid(wv);
    { float cv[18];
#pragma unroll
      for (int q = 0; q < 18; ++q) { const int i = tid + q * 512; const int r = i >> 10, k = i & 1023; cv[q] = (r < 8) ? p.c[r * 1024 + k] : p.c_ctx[k]; }
      __builtin_amdgcn_sched_barrier(0);
#pragma unroll
      for (int q = 0; q < 18; ++q) sc[tid + q * 512] = silu_f(cv[q]); }
    __syncthreads();
    const int cl = tid & 31, kg = tid >> 5, col = blockIdx.x * 32 + cl;
    float acc[9];
#pragma unroll
    for (int r = 0; r < 9; ++r) acc[r] = 0.f;
#pragma unroll
    for (int kb = 0; kb < 64; kb += 32) { float w[32];
#pragma unroll
        for (int q = 0; q < 32; ++q) w[q] = p.w_mod[(size_t)(kg * 64 + kb + q) * 3072 + col];
        __builtin_amdgcn_sched_barrier(0);
#pragma unroll
        for (int q = 0; q < 32; ++q) { const int k = kg * 64 + kb + q;
#pragma unroll
            for (int r = 0; r < 9; ++r) acc[r] += sc[r * 1024 + k] * w[q]; } }
#pragma unroll
    for (int r = 0; r < 9; ++r) part[(kg * 9 + r) * 32 + cl] = acc[r];
    __syncthreads();
    if (tid < 288) { const int r = tid >> 5, c2 = tid & 31; float s = 0.f;
        for (int g = 0; g < 16; ++g) s += part[(g * 9 + r) * 32 + c2];
        const int n = blockIdx.x * 32 + c2; MOD[r * 3072 + n] = s + p.b_mod[n]; }
    __syncthreads();
}
__device__ __forceinline__ void phase_weights(const Params& p, char* lds, int wv, int part, int b0) {
    bf16_t* WinT = (bf16_t*)(p.ws + WS_WIN); bf16_t* WuqT = (bf16_t*)(p.ws + WS_WUQ); bf16_t* WukvT = (bf16_t*)(p.ws + WS_WUKV);
    bf16_t* WoutT = (bf16_t*)(p.ws + WS_WOUT);
    constexpr long C0 = 128L * 2048, C1 = C0 + 32L * 768, C2 = C1 + 16L * 1024, C3 = C2 + 128L * 1024, C4 = C3;
    const int tid = fresh_tid(wv);
    const long itLo = part ? C0 : 0, itHi = part ? C4 : C0; const int nbw = (int)gridDim.x - b0;
    for (long it = itLo + ((long)blockIdx.x - b0) * 512 + tid; it < itHi && (int)blockIdx.x >= b0; it += (long)nbw * 512) {
        float v[8]; bf16_t* dst;
        if (it < C0) { const int n = (int)(it % 2048), k8 = (int)(it / 2048);
#pragma unroll
            for (int e = 0; e < 8; ++e) v[e] = p.w_in[(size_t)(k8 * 8 + e) * 1984 + (n < 1984 ? n : 1983)];
            if (n >= 1984) {
#pragma unroll
                for (int e = 0; e < 8; ++e) v[e] = 0.f; }
            if (n >= OFF_PIN && n < OFF_GP) continue;
            dst = WinT + (size_t)n * 1024 + k8 * 8; }
        else if (it < C1) { const long i2 = it - C0; const int n = (int)(i2 % 768), k8 = (int)(i2 / 768);
#pragma unroll
            for (int e = 0; e < 8; ++e) v[e] = p.w_uq[(size_t)(k8 * 8 + e) * 768 + n] * p.q_lora_g[k8 * 8 + e];
            dst = WuqT + (size_t)n * 256 + k8 * 8; }
        else if (it < C2) { const long i2 = it - C1; const int n = (int)(i2 % 1024), k8 = (int)(i2 / 1024);
#pragma unroll
            for (int e = 0; e < 8; ++e) v[e] = p.w_ukv[(size_t)(k8 * 8 + e) * 1024 + n] * p.kv_lora_g[k8 * 8 + e];
            dst = WukvT + (size_t)n * 128 + k8 * 8; }
        else { const long i2 = it - C2; const int n = (int)(i2 % 1024), k8 = (int)(i2 / 1024);
#pragma unroll
            for (int e = 0; e < 8; ++e) v[e] = p.w_out[(size_t)(k8 * 8 + e) * 1024 + n];
            dst = WoutT + (size_t)n * 1024 + k8 * 8; }
        *(u32x4*)dst = pack8(v);
    }
    if (part == 0) {   float* wpS = (float*)lds; float* wiS = wpS + 128 * 128;
        for (int item = gridDim.x - 1 - blockIdx.x; item < 4 * 32; item += gridDim.x) {
            const int g = item >> 5, k0 = (item & 31) * 32;
            __syncthreads();
            for (int i = tid; i < 128 * 128 / 4; i += 512) *(f32x4*)(wpS + i * 4) = *(const f32x4*)(p.w_pool + (size_t)g * 128 * 128 + i * 4);
            for (int i = tid; i < 32 * 128 / 4; i += 512) { const int kk = i >> 5, c4 = (i & 31) * 4; *(f32x4*)(wiS + kk * 128 + c4) = *(const f32x4*)(p.w_in + (size_t)(k0 + kk) * 1984 + OFF_PIN + g * 128 + c4); }
            __syncthreads();
            const int d = tid & 127, kq = tid >> 7;
            float v[8];
#pragma unroll
            for (int e = 0; e < 8; ++e) v[e] = 0.f;
            for (int c = 0; c < 128; c += 4) { float wq[4];
#pragma unroll
                for (int q = 0; q < 4; ++q) wq[q] = wpS[(c + q) * 128 + d];
#pragma unroll
                for (int e = 0; e < 8; ++e) { const f32x4 a = *(const f32x4*)(wiS + (kq * 8 + e) * 128 + c); v[e] += a[0] * wq[0] + a[1] * wq[1] + a[2] * wq[2] + a[3] * wq[3]; } }
            *(u32x4*)(WinT + (size_t)(OFF_PIN + g * 128 + d) * 1024 + k0 + kq * 8) = pack8(v);
        }
        __syncthreads();
    }
    if (part == 0 && blockIdx.x == gridDim.x - 1) {
        float* ROPEC = (float*)(p.ws + WS_ROPE); float* ROPES = ROPEC + 1024;
        for (int i = tid; i < 1024; i += 512) { const int pos = i >> 4, f = i & 15;
            const float inv = exp2f(-(float)f * (13.287712379549449f / 16.f)); const float ang = (float)pos * inv;
            ROPEC[i] = cosf(ang); ROPES[i] = sinf(ang); }
    }
}
__device__ __forceinline__ void phase_norm(const Params& p, int wv) {
    const float* MOD = (const float*)(p.ws + WS_MOD); bf16_t* H = (bf16_t*)(p.ws + WS_H);
    const int tid = fresh_tid(wv), lane = tid & 63, wid = tid >> 6;
    for (int r = blockIdx.x * 8 + wid; r < MT; r += gridDim.x * 8) {
        const int b = r / LK, j = r - b * LK;
        const float* src = (j < CL) ? p.ctx + ((size_t)b * CL + j) * 1024 : p.x + ((size_t)b * SEQ + (j - CL)) * 1024;
        const float* mrow = MOD + ((j < CL) ? 8 : b) * 3072;
        float v[16]; float ss = 0.f;
#pragma unroll
        for (int i = 0; i < 2; ++i) { const f32x4 a0 = *(const f32x4*)(src + i * 512 + lane * 8), a1 = *(const f32x4*)(src + i * 512 + lane * 8 + 4);
#pragma unroll
            for (int e = 0; e < 4; ++e) { v[i * 8 + e] = a0[e]; v[i * 8 + 4 + e] = a1[e]; } }
#pragma unroll
        for (int e = 0; e < 16; ++e) ss += v[e] * v[e];
#pragma unroll
        for (int s = 1; s < 64; s <<= 1) ss += __shfl_xor(ss, s);
        const float rstd = rsqrtf(ss * (1.f / 1024.f) + EPS);
#pragma unroll
        for (int i = 0; i < 2; ++i) { const int k0 = i * 512 + lane * 8; float o[8];
#pragma unroll
            for (int e4 = 0; e4 < 2; ++e4) { const f32x4 g = *(const f32x4*)(p.norm_g + k0 + e4 * 4), sh = *(const f32x4*)(mrow + k0 + e4 * 4), scl = *(const f32x4*)(mrow + 1024 + k0 + e4 * 4);
#pragma unroll
                for (int e = 0; e < 4; ++e) o[e4 * 4 + e] = v[i * 8 + e4 * 4 + e] * rstd * g[e] * (1.f + scl[e]) + sh[e]; }
            *(u32x4*)(H + (size_t)r * 1024 + k0) = pack8(o); }
    }
}
template <int W>
__device__ __forceinline__ void pooled_item(const bf16_t* __restrict__ Ub, bf16_t* __restrict__ BRb, const float* __restrict__ psc, int g, int t0, int cc) {
    constexpr int NR = W + 3; const int ch = g * 128 + cc * 8;
    u32x4 rows[NR]; u32x4 gts[4];
#pragma unroll
    for (int i = 0; i < NR; ++i) { const int tt = t0 - W / 2 + i; const int tc = tt < 0 ? 0 : (tt >= SEQ ? SEQ - 1 : tt);
        rows[i] = *(const u32x4*)(Ub + (size_t)tc * NINP + OFF_PIN + ch);
        if (tt < 0 || tt >= SEQ) rows[i] = (u32x4){0u, 0u, 0u, 0u}; }
#pragma unroll
    for (int q = 0; q < 4; ++q) gts[q] = *(const u32x4*)(Ub + (size_t)(t0 + q) * NINP + OFF_GP + ch);
    const f32x4 p0 = *(const f32x4*)(psc + ch), p1 = *(const f32x4*)(psc + ch + 4);
    __builtin_amdgcn_sched_barrier(0);
    float s[8];
#pragma unroll
    for (int e = 0; e < 8; ++e) s[e] = 0.f;
#pragma unroll
    for (int i = 0; i < W; ++i) { float f[8]; unpack8(rows[i], f);
#pragma unroll
        for (int e = 0; e < 8; ++e) s[e] += f[e]; }
#pragma unroll
    for (int q = 0; q < 4; ++q) { const int t = t0 + q;
        if (q > 0) { float fo[8], fn[8]; unpack8(rows[q - 1], fo); unpack8(rows[q - 1 + W], fn);
#pragma unroll
            for (int e = 0; e < 8; ++e) s[e] += fn[e] - fo[e]; }
        const int lo = max(t - W / 2, 0), hi = min(t - W / 2 + W, SEQ); const float inv = 1.f / (float)(hi - lo);
        float xt[8]; unpack8(rows[q + W / 2], xt); float gt[8]; unpack8(gts[q], gt); float o[8];
#pragma unroll
        for (int e = 0; e < 8; ++e) o[e] = (s[e] * inv - xt[e]) * silu_f(gt[e]) * ((e < 4) ? p0[e & 3] : p1[e & 3]);
        *(u32x4*)(BRb + (size_t)t * 1024 + 512 + ch) = pack8(o); }
}
__device__ __forceinline__ void phase_pooled(const Params& p, int wv) {
    const bf16_t* U = (const bf16_t*)(p.ws + WS_U); bf16_t* BR = (bf16_t*)(p.ws + WS_BR);
    const int tid = fresh_tid(wv), lane = tid & 63, wid = tid >> 6;
    const int bidp = blockIdx.x; const bool bal = gridDim.x == 256;
    const int nr = bal ? (bidp < 32 ? 2 : (bidp < 128 ? 6 : 3)) : (1024 - bidp + (int)gridDim.x - 1) / (int)gridDim.x;
    const int r0 = bal ? (bidp < 32 ? bidp * 2 : (bidp < 128 ? 64 + (bidp - 32) * 6 : 640 + (bidp - 128) * 3)) : bidp;
    const int rstep = bal ? 1 : (int)gridDim.x;
    for (int rr = 0; rr < nr; ++rr) { const int wi = (r0 + rr * rstep) * 8 + wid;
        const int rg = wi & 255, g = (wi >> 8) & 3, b = wi >> 10;
        const int t0 = rg * 16 + (lane >> 4) * 4, cc = lane & 15;
        const bf16_t* Ub = U + ((size_t)b * LK + CL) * NINP; bf16_t* BRb = BR + (size_t)b * SEQ * 1024;
        if (g == 0) pooled_item<2>(Ub, BRb, p.pool_scale, g, t0, cc); else if (g == 1) pooled_item<4>(Ub, BRb, p.pool_scale, g, t0, cc);
        else if (g == 2) pooled_item<8>(Ub, BRb, p.pool_scale, g, t0, cc); else pooled_item<16>(Ub, BRb, p.pool_scale, g, t0, cc);
    }
}
#define XB_TMO      128
#define XB_XCNT(j)  (256  + 64 * (j))
#define XB_XSUB(j)  (1280 + 64 * (j))
#define XB_XGEN(j)  (2304 + 64 * (j))
#define XB_TOP      3328
#define XB_TOPGEN   3392
#define XCD_BAR_WORDS 3456
#define XB_SPIN_CAP (1u << 20)
__device__ __forceinline__ unsigned xb_ld(unsigned* p)              { return __hip_atomic_load(p, __ATOMIC_RELAXED, __HIP_MEMORY_SCOPE_AGENT); }
__device__ __forceinline__ unsigned xb_add(unsigned* p, unsigned v) { return __hip_atomic_fetch_add(p, v, __ATOMIC_RELAXED, __HIP_MEMORY_SCOPE_AGENT); }
__device__ __forceinline__ unsigned xb_xcc_id() { return (unsigned)__builtin_amdgcn_s_getreg((3 << 11) | 20) & 0xFu; }
#define XB_SPIN(cond, bar) do { unsigned _sp = 0; while (cond) { __builtin_amdgcn_s_sleep(1); \
    if ((++_sp & 255u) == 0u) { if (xb_ld(&(bar)[XB_TMO])) break; if (_sp > XB_SPIN_CAP) { atomicAdd(&(bar)[XB_TMO], 1u); break; } } } } while (0)
__device__ __forceinline__ void xcd_barrier_complete(unsigned* bar, unsigned x, unsigned& nloc, unsigned& nx) {
    const unsigned G = gridDim.x;
    unsigned sum, cnt, mine, sp = 0u;
    for (;;) {
        sum = 0u; cnt = 0u; mine = 0u;
#pragma unroll
        for (unsigned j = 0; j < 16; ++j) { const unsigned c = xb_ld(&bar[XB_XCNT(j)]); sum += c; cnt += (c > 0u) ? 1u : 0u; mine = (j == x) ? c : mine; }
        if (sum == G) break;
        __builtin_amdgcn_s_sleep(1);
        if ((++sp & 255u) == 0u) { if (xb_ld(&bar[XB_TMO])) break; if (sp > XB_SPIN_CAP) { atomicAdd(&bar[XB_TMO], 1u); break; } }
    }
    nloc = mine > 0u ? mine : 1u; nx = cnt > 0u ? cnt : 1u;
}
__device__ __forceinline__ void grid_bar(unsigned* bar, volatile LAS unsigned* st, int wv) {
    asm volatile("s_waitcnt vmcnt(0)" ::: "memory");
    __syncthreads();
    if (fresh_tid(wv) == 0) {
        __builtin_amdgcn_s_waitcnt(0);
        const unsigned x = xb_xcc_id();
        unsigned nloc = st[0], nx = st[1];
        if (nloc == 0u) { xcd_barrier_complete(bar, x, nloc, nx); st[0] = nloc; st[1] = nx; }
        const unsigned old = xb_add(&bar[XB_XSUB(x)], 1u);
        const unsigned gen = old / nloc;
        if (old + 1u == (gen + 1u) * nloc) {
            __builtin_amdgcn_fence(__ATOMIC_RELEASE, "agent");
            asm volatile("s_waitcnt vmcnt(0)" ::: "memory");
            const unsigned og = xb_add(&bar[XB_TOP], 1u);
            const unsigned tg = og / nx;
            if (og + 1u == (tg + 1u) * nx) xb_add(&bar[XB_TOPGEN], 1u);
            else XB_SPIN(xb_ld(&bar[XB_TOPGEN]) == tg, bar);
            __builtin_amdgcn_fence(__ATOMIC_ACQUIRE, "agent");
            xb_add(&bar[XB_XGEN(x)], 1u);
            asm volatile("s_waitcnt vmcnt(0)" ::: "memory");
        } else {
            XB_SPIN(xb_ld(&bar[XB_XGEN(x)]) == gen, bar);
            __builtin_amdgcn_fence(__ATOMIC_ACQUIRE, "agent");
            asm volatile("s_waitcnt vmcnt(0)" ::: "memory");
        }
    }
    __syncthreads();
}
#ifndef PROBE_SUB
#define PROBE_SUB 0x11111
#endif
__device__ __forceinline__ int opaque_sub(int k) { int n = (PROBE_SUB >> (4 * k)) & 15; asm volatile("" : "+s"(n)); return n; }
#define REPSUB(k) for (int rs_ = 0, nrs_ = opaque_sub(k); rs_ < nrs_; ++rs_)
#ifndef PROBE_REP
#define PROBE_REP 0x1111111
#endif
__device__ __forceinline__ int opaque_rep(int k) { int n = (PROBE_REP >> (4 * k)) & 15; asm volatile("" : "+s"(n)); return n; }
constexpr int LDS_BYTES = pg8::STAGE_BYTES + 4096 + 64;
static_assert(SHM_ATTN <= LDS_BYTES, "lds");
static_assert(9 * 1024 * 4 + 16 * 9 * 32 * 4 <= LDS_BYTES, "lds");

__global__ void __launch_bounds__(512, 2) fwd_megakernel(Params p) {
    extern __shared__ __attribute__((aligned(16))) unsigned char smem[];
    cg::grid_group grid = cg::this_grid();
    const int G = gridDim.x, bid = blockIdx.x;
    int wv = __builtin_amdgcn_readfirstlane(threadIdx.x >> 6); asm volatile("" : "+s"(wv));
    unsigned* bar_words = (unsigned*)(p.ws + WS_BAR); volatile LAS unsigned* bar_st = (volatile LAS unsigned*)((LAS unsigned char*)smem + pg8::STAGE_BYTES + 4096);
    if (fresh_tid(wv) == 0) { bar_st[0] = 0u; bar_st[1] = 0u; (void)xb_add(&bar_words[XB_XCNT(xb_xcc_id())], 1u); }
    if (G > (1 << 20)) grid.sync();
#define GBAR() grid_bar(bar_words, bar_st, wv)
    bf16_t* H = (bf16_t*)(p.ws + WS_H); bf16_t* U = (bf16_t*)(p.ws + WS_U); bf16_t* BR = (bf16_t*)(p.ws + WS_BR);
#define REPEAT(k) for (int rep_ = 0, nrep_ = opaque_rep(k); rep_ < nrep_; ++rep_)
    REPEAT(0) {
    if (bid < 96) phase_mod(p, (char*)smem, wv);
    phase_weights(p, (char*)smem, wv, 0, 0);
    GBAR(); }
    REPEAT(1) {
    phase_norm(p, wv);
    GBAR(); }
    REPEAT(2) {
    { pg8::Gemm g{H, (const bf16_t*)(p.ws + WS_WIN), 1024, 1024, 1024}; pg8::StaticOrder S; S.init(MT / 256, NINP / 256, G, bid);
      pg8::EpiU E{U, (float*)(p.ws + WS_SSQ), (float*)(p.ws + WS_SSKV), (float*)(p.ws + WS_SSKR)};
      pg8::gemm_phase(( LAS unsigned char*)smem, g, S, E, wv); }
    { const int nfive = (MT / 256) * (NINP / 256) - 4 * G;
      phase_weights(p, (char*)smem, wv, 1, (nfive > 0 && nfive < G) ? nfive : 0); }
    GBAR(); }
    REPEAT(3) {
    REPSUB(0)
    { pg8::Gemm g{U, (const bf16_t*)(p.ws + WS_WUQ), NINP, 256, 256}; pg8::StaticOrder S; S.init(ML / 256, 3, G, (bid + 128) % G); S.latent = 1;
      pg8::EpiStore E{(bf16_t*)(p.ws + WS_QRAW), 768};
      pg8::gemm_phase((LAS unsigned char*)smem, g, S, E, wv); }
    REPSUB(1)
    { pg8::Gemm g{U + OFF_CKV, (const bf16_t*)(p.ws + WS_WUKV), NINP, 128, 128}; pg8::StaticOrder S; S.init(MT / 256, 4, G, bid);
      pg8::EpiKV E{(char*)(p.ws + WS_KIMG), (bf16_t*)(p.ws + WS_V), U, (const float*)(p.ws + WS_SSKV), (const float*)(p.ws + WS_SSKR), p.k_norm_g, (const float*)(p.ws + WS_ROPE), (LAS float*)(smem + pg8::STAGE_BYTES)};
      pg8::gemm_phase((LAS unsigned char*)smem, g, S, E, wv); }
    REPSUB(2) { phase_pooled(p, wv); __syncthreads(); }
    GBAR(); }
    REPEAT(5) {
    { const int xcd = bid & 7, s = bid >> 3;
      if (G == 256) { for (int it = 0; it < 2; ++it) { const int grp = xcd * 4 + it * 2 + (s >> 4); __syncthreads(); attn_item(p, grp >> 2, grp & 3, s & 15, (char*)smem, wv); } }
      else { for (int item = bid; item < 512; item += G) { __syncthreads(); attn_item(p, item >> 6, (item >> 4) & 3, item & 15, (char*)smem, wv); } }
    }
    GBAR(); }
    REPEAT(6) {
    { pg8::Gemm g{BR, (const bf16_t*)(p.ws + WS_WOUT), 1024, 1024, 1024}; pg8::StaticOrder S; S.init(ML / 256, 4, G, bid);
      pg8::EpiOut E{p.out, p.x, (const float*)(p.ws + WS_MOD)};
      pg8::gemm_phase((LAS unsigned char*)smem, g, S, E, wv); }
    __syncthreads(); }
}

extern "C" void kernel_launch(void* const* d_in, const int* in_sizes, int n_in, void* d_out, int out_size, void* d_ws, size_t ws_size, hipStream_t stream) {
    static int grid_blocks = 0;
    if (grid_blocks == 0) {
        if (n_in != 17 || ws_size < WS_END) { fprintf(stderr, "kernel_launch: bad n_in %d or ws %zu < %zu\n", n_in, ws_size, (size_t)WS_END); grid_blocks = -1; return; }
        int dev = 0, cus = 0, per_cu = 0;
        hipGetDevice(&dev);
        hipDeviceGetAttribute(&cus, hipDeviceAttributeMultiprocessorCount, dev);
        if (hipFuncSetAttribute((const void*)fwd_megakernel, hipFuncAttributeMaxDynamicSharedMemorySize, LDS_BYTES) != hipSuccess) { fprintf(stderr, "hipFuncSetAttribute failed\n"); grid_blocks = -1; return; }
        if (hipOccupancyMaxActiveBlocksPerMultiprocessor(&per_cu, (const void*)fwd_megakernel, 512, LDS_BYTES) != hipSuccess || per_cu < 1) { fprintf(stderr, "occupancy query failed (%d)\n", per_cu); grid_blocks = -1; return; }
        grid_blocks = cus * per_cu;
    }
    if (grid_blocks < 0) return;
    Params p{};
    p.x = (const float*)d_in[0]; p.c = (const float*)d_in[1]; p.ctx = (const float*)d_in[2]; p.c_ctx = (const float*)d_in[3];
    p.w_mod = (const float*)d_in[4]; p.b_mod = (const float*)d_in[5]; p.norm_g = (const float*)d_in[6]; p.w_in = (const float*)d_in[7];
    p.q_lora_g = (const float*)d_in[8]; p.w_uq = (const float*)d_in[9]; p.kv_lora_g = (const float*)d_in[10]; p.w_ukv = (const float*)d_in[11];
    p.q_norm_g = (const float*)d_in[12]; p.k_norm_g = (const float*)d_in[13]; p.w_pool = (const float*)d_in[14]; p.pool_scale = (const float*)d_in[15];
    p.w_out = (const float*)d_in[16]; p.out = (float*)d_out; p.ws = (unsigned char*)d_ws;
    if (hipMemsetAsync((char*)d_ws + WS_BAR, 0, 16384, stream) != hipSuccess) { fprintf(stderr, "memset failed\n"); return; }
    void* args[] = {&p};
    hipError_t e = hipLaunchCooperativeKernel((const void*)fwd_megakernel, dim3(grid_blocks), dim3(512), args, LDS_BYTES, stream);
    if (e != hipSuccess) fprintf(stderr, "cooperative launch failed: %s (grid %d)\n", hipGetErrorString(e), grid_blocks);
}
```

```cpp
#include <hip/hip_runtime.h>
#include <hip/hip_cooperative_groups.h>
#include <cstdio>
#include <cstdint>
namespace cg = cooperative_groups;

#define LAS __attribute__((address_space(3)))
typedef unsigned short bf16_t;
typedef short bf16x8 __attribute__((ext_vector_type(8)));
typedef short s16x4 __attribute__((ext_vector_type(4)));
typedef float f32x4 __attribute__((ext_vector_type(4)));
typedef float f32x16 __attribute__((ext_vector_type(16)));
typedef unsigned u32x4 __attribute__((ext_vector_type(4)));

constexpr int NB = 8, SEQ = 4096, DM = 1024, CL = 256, LK = SEQ + CL;
constexpr int MT = NB * LK;
constexpr int ML = NB * SEQ;
constexpr int NINP = 2048;
constexpr int OFF_CKV = 256, OFF_KR = 384, OFF_GA = 448, OFF_PIN = 960, OFF_GP = 1472;
constexpr int NH = 4, DQK = 192, DV = 128;
constexpr float EPS = 1e-6f;
constexpr int NTILE = LK / 64;
constexpr int KIMG_B = 64 * DQK * 2;

constexpr size_t al256(size_t x) { return (x + 255) / 256 * 256; }
constexpr size_t WS_BAR = 0;
constexpr size_t WS_MOD = 16384;
constexpr size_t WS_ROPE = WS_MOD + al256(9 * 3072 * 4);
constexpr size_t WS_SSQ = WS_ROPE + al256(2 * 1024 * 4);
constexpr size_t WS_SSKV = WS_SSQ + al256((size_t)MT * 16);
constexpr size_t WS_SSKR = WS_SSKV + al256((size_t)MT * 16);
constexpr size_t WS_WIN = WS_SSKR + al256((size_t)MT * 16);
constexpr size_t WS_WUQ = WS_WIN + al256((size_t)NINP * 1024 * 2);
constexpr size_t WS_WUKV = WS_WUQ + al256((size_t)768 * 256 * 2);
constexpr size_t WS_WP = WS_WUKV + al256((size_t)1024 * 128 * 2);
constexpr size_t WS_WOUT = WS_WP + al256((size_t)2 * 256 * 256 * 2);
constexpr size_t WS_H = WS_WOUT + al256((size_t)1024 * 1024 * 2);
constexpr size_t WS_U = WS_H + al256((size_t)MT * 1024 * 2);
constexpr size_t WS_QRAW = WS_U + al256((size_t)MT * NINP * 2);
constexpr size_t WS_KN = WS_QRAW + al256((size_t)MT * 768 * 2);
constexpr size_t WS_V = WS_KN + al256((size_t)MT * NH * 128 * 2);
constexpr size_t WS_KIMG = WS_V + al256((size_t)MT * NH * 128 * 2);
constexpr size_t WS_POOLED = WS_KIMG + al256((size_t)NB * NH * NTILE * KIMG_B);
constexpr size_t WS_END0 = WS_POOLED + al256((size_t)ML * 512 * 2);
constexpr size_t WS_BR = WS_H;
constexpr size_t WS_END = WS_END0;

struct Params {
    const float *x, *c, *ctx, *c_ctx, *w_mod, *b_mod, *norm_g, *w_in, *q_lora_g, *w_uq, *kv_lora_g, *w_ukv, *q_norm_g, *k_norm_g, *w_pool, *pool_scale, *w_out;
    float* out; unsigned char* ws;
};

__device__ __forceinline__ unsigned cvtpk(float lo, float hi) { unsigned r; asm volatile("v_cvt_pk_bf16_f32 %0, %1, %2" : "=v"(r) : "v"(lo), "v"(hi)); return r; }
__device__ __forceinline__ float bf2f(unsigned short u) { return __uint_as_float(((unsigned)u) << 16); }
__device__ __forceinline__ float bflo(unsigned w) { return __uint_as_float(w << 16); }
__device__ __forceinline__ float bfhi(unsigned w) { return __uint_as_float(w & 0xffff0000u); }
__device__ __forceinline__ unsigned short f2bf(float f) { unsigned u = __float_as_uint(f); u += 0x7FFFu + ((u >> 16) & 1u); return (unsigned short)(u >> 16); }
__device__ __forceinline__ int fresh_tid(int w) {
    int l; asm volatile("v_mbcnt_lo_u32_b32 %0, -1, 0\n\tv_mbcnt_hi_u32_b32 %0, -1, %0" : "=v"(l));
    return (w << 6) | l; }
__device__ __forceinline__ float silu_f(float v) { return v * __builtin_amdgcn_rcpf(1.f + __expf(-v)); }
__device__ __forceinline__ void unpack8(u32x4 w, float* o) { o[0] = bflo(w.x); o[1] = bfhi(w.x); o[2] = bflo(w.y); o[3] = bfhi(w.y); o[4] = bflo(w.z); o[5] = bfhi(w.z); o[6] = bflo(w.w); o[7] = bfhi(w.w); }
__device__ __forceinline__ u32x4 pack8(const float* v) { u32x4 w; w.x = cvtpk(v[0], v[1]); w.y = cvtpk(v[2], v[3]); w.z = cvtpk(v[4], v[5]); w.w = cvtpk(v[6], v[7]); return w; }

namespace pg8 {
constexpr int BM = 256, BK = 64, HALF = 128, HTB = HALF * BK * 2, STAGE_BYTES = 8 * HTB, NXCD = 8, WGM = 8;
__device__ __forceinline__ int lds_byte(int r, int c) { const int st = (r >> 4) * 2 + (c >> 5), rr = r & 15, cc = c & 31, ob = rr * 64 + cc * 2; return st * 1024 + (ob ^ (((ob >> 9) & 1) << 5)); }
__device__ __forceinline__ void stage_rc(int b, int& R, int& C) { const int st = b / 1024, sb = b % 1024, swz = sb ^ (((sb >> 9) & 1) << 5); R = (st >> 1) * 16 + swz / 64; C = (st & 1) * 32 + (swz % 64) / 2; }
__device__ __forceinline__ int perm32(int rho) { const int n = rho >> 4, i = rho & 15; return 8 * (i >> 2) + 4 * n + (i & 3); }
struct Unit { int pm, pn; };
struct Gemm { const bf16_t* A; const bf16_t* Bt; int lda, ldb, K; };
struct StaticOrder {
    int nM, nN, nwg, G, c;
    __device__ void init(int nM_, int nN_, int G_, int c_) { nM = nM_; nN = nN_; nwg = nM * nN; G = G_; c = c_; }
    __device__ bool next(int i, Unit& u) const {
        const long L = (long)i * G + c; if (L >= nwg) return false;
        int wgid = (int)L; { const int q = nwg / NXCD, r = nwg % NXCD, xcd = wgid % NXCD, off = wgid / NXCD; wgid = (xcd < r ? xcd * (q + 1) : r * (q + 1) + (xcd - r) * q) + off; }
        const int nig = WGM * nN, gid = wgid / nig, fm = gid * WGM, gsz = (nM - fm) < WGM ? (nM - fm) : WGM;
        u.pm = fm + ((wgid % nig) % gsz); u.pn = (wgid % nig) / gsz;
        if (latent) u.pm = (u.pm >> 4) * 17 + 1 + (u.pm & 15);
        return true;
    }
    int latent = 0;
};
template <class Epi, class Sched>
__device__ __forceinline__ void gemm_phase(LAS unsigned char* lds, const Gemm g, const Sched& S, const Epi& E, int wv) {
    const int tid = fresh_tid(wv), wid = __builtin_amdgcn_readfirstlane(tid >> 6), lane = tid & 63, wr = wid >> 2, wc = wid & 3, fr = lane & 15, fq = lane >> 4;
    const int K = g.K, nt = K / BK;
    unsigned voffA[2], voffB[2];
#pragma unroll
    for (int i = 0; i < 2; ++i) { int R, C; stage_rc(tid * 16 + i * 8192, R, C); const int Rb = Epi::PERM ? ((R & ~31) + perm32(R & 31)) : R;
        voffA[i] = (unsigned)(R * g.lda + C) * 2u; voffB[i] = (unsigned)(Rb * g.ldb + C) * 2u; }
    const size_t kstep = (size_t)(BK * 2);
    const size_t hstepA = (size_t)HALF * g.lda * 2, hstepB = (size_t)HALF * g.ldb * 2;
    const size_t tstepA = 2 * hstepA, tstepB = 2 * hstepB;
    const unsigned ldsw = (unsigned)wid * 1024u;
    const int aoff = lds_byte(wr * 64 + fr, fq * 8), boff = lds_byte(wc * 32 + fr, fq * 8);
#define PG8_SA(b, h) (((b) * 2 + (h)) * HTB)
#define PG8_SB(b, h) ((4 + (b) * 2 + (h)) * HTB)
#define PG8_STAGE(bufoff, gbase, voff) do { _Pragma("unroll") for (int _i = 0; _i < 2; ++_i) \
        __builtin_amdgcn_global_load_lds((const unsigned*)((const char*)(gbase) + (voff)[_i]), (LAS unsigned*)(lds + (bufoff) + ldsw + _i * 8192), 16, 0, 0); } while (0)
#define PG8_LDA(dst, b, h) do { _Pragma("unroll") for (int m = 0; m < 4; ++m) _Pragma("unroll") for (int k = 0; k < 2; ++k) dst[m][k] = *(const LAS bf16x8*)(lds + PG8_SA(b, h) + aoff + m * 2048 + k * 1024); } while (0)
#define PG8_LDB(dst, b, h) do { _Pragma("unroll") for (int n = 0; n < 2; ++n) _Pragma("unroll") for (int k = 0; k < 2; ++k) dst[n][k] = *(const LAS bf16x8*)(lds + PG8_SB(b, h) + boff + n * 2048 + k * 1024); } while (0)
#define PG8_MMA(ai, bj, At, Bt) do { __builtin_amdgcn_s_setprio(1); _Pragma("unroll") for (int m = 0; m < 4; ++m) _Pragma("unroll") for (int n = 0; n < 2; ++n) _Pragma("unroll") for (int k = 0; k < 2; ++k) \
        acc[ai][bj][m][n] = __builtin_amdgcn_mfma_f32_16x16x32_bf16(Bt[n][k], At[m][k], acc[ai][bj][m][n], 0, 0, 0); __builtin_amdgcn_s_setprio(0); } while (0)
#define PG8_WAIT_V(n) asm volatile("s_waitcnt vmcnt(" #n ")" ::: "memory")
#define PG8_WAIT_L(n) asm volatile("s_waitcnt lgkmcnt(" #n ")" ::: "memory")
#define PG8_BAR __builtin_amdgcn_s_barrier()
#define PG8_SCHED __builtin_amdgcn_sched_barrier(0)
    Unit cur, nxt; int ui = 0;
    if (!S.next(0, cur)) return;
    f32x4 acc[2][2][4][2];
#pragma unroll
    for (int a = 0; a < 2; ++a)
#pragma unroll
        for (int b = 0; b < 2; ++b)
#pragma unroll
            for (int m = 0; m < 4; ++m)
#pragma unroll
                for (int n = 0; n < 2; ++n) acc[a][b][m][n] = (f32x4){0.f, 0.f, 0.f, 0.f};
    bf16x8 At[4][2], B0[2][2], B1[2][2];
    const char* cA = (const char*)g.A + (size_t)cur.pm * tstepA; const char* cB = (const char*)g.Bt + (size_t)cur.pn * tstepB;
    PG8_STAGE(PG8_SB(0, 0), cB, voffB); PG8_STAGE(PG8_SA(0, 0), cA, voffA); PG8_STAGE(PG8_SB(0, 1), cB + hstepB, voffB); PG8_STAGE(PG8_SA(0, 1), cA + hstepA, voffA);
    if (wr == 1) PG8_BAR;
    PG8_WAIT_V(4); PG8_BAR;
    PG8_STAGE(PG8_SB(1, 0), cB + kstep, voffB); PG8_STAGE(PG8_SA(1, 0), cA + kstep, voffA); PG8_STAGE(PG8_SB(1, 1), cB + hstepB + kstep, voffB);
    PG8_WAIT_V(6); PG8_BAR;
    for (;;) {
        const bool has_next = S.next(ui + 1, nxt);
        const char* nA = has_next ? (const char*)g.A + (size_t)nxt.pm * tstepA : cA; const char* nB = has_next ? (const char*)g.Bt + (size_t)nxt.pn * tstepB : cB;
        for (int t = 0; t < nt; t += 2) {
            const bool last = (t == nt - 2);
            const char* a1 = cA + (size_t)(t + 1) * kstep;
            const char* a2 = last ? nA : cA + (size_t)(t + 2) * kstep; const char* b2 = last ? nB : cB + (size_t)(t + 2) * kstep;
            const char* a3 = a2 + kstep; const char* b3 = b2 + kstep;
            PG8_LDB(B0, 0, 0); PG8_SCHED; PG8_LDA(At, 0, 0); PG8_STAGE(PG8_SA(1, 1), a1 + hstepA, voffA);
            PG8_WAIT_L(8); PG8_BAR; PG8_WAIT_L(0); PG8_MMA(0, 0, At, B0); PG8_BAR; PG8_SCHED;
            PG8_LDB(B1, 0, 1); PG8_STAGE(PG8_SB(0, 0), b2, voffB);
            PG8_BAR; PG8_WAIT_L(0); PG8_MMA(0, 1, At, B1); PG8_BAR;
            PG8_LDA(At, 0, 1); PG8_STAGE(PG8_SA(0, 0), a2, voffA);
            PG8_BAR; PG8_WAIT_L(0); PG8_MMA(1, 0, At, B0); PG8_BAR; PG8_SCHED;
            PG8_STAGE(PG8_SB(0, 1), b2 + hstepB, voffB);
            PG8_WAIT_V(6); PG8_BAR; PG8_MMA(1, 1, At, B1); PG8_BAR;
            PG8_LDB(B0, 1, 0); PG8_SCHED; PG8_LDA(At, 1, 0); PG8_STAGE(PG8_SA(0, 1), a2 + hstepA, voffA);
            PG8_WAIT_L(8); PG8_BAR; PG8_WAIT_L(0); PG8_MMA(0, 0, At, B0); PG8_BAR; PG8_SCHED;
            PG8_LDB(B1, 1, 1); PG8_STAGE(PG8_SB(1, 0), b3, voffB);
            PG8_BAR; PG8_WAIT_L(0); PG8_MMA(0, 1, At, B1); PG8_BAR;
            PG8_LDA(At, 1, 1); PG8_STAGE(PG8_SA(1, 0), a3, voffA);
            PG8_BAR; PG8_WAIT_L(0); PG8_MMA(1, 0, At, B0); PG8_BAR; PG8_SCHED;
            PG8_STAGE(PG8_SB(1, 1), b3 + hstepB, voffB);
            PG8_WAIT_V(6); PG8_BAR; PG8_MMA(1, 1, At, B1); PG8_BAR;
        }
        { int l2; asm volatile("v_mbcnt_lo_u32_b32 %0, -1, 0\n\tv_mbcnt_hi_u32_b32 %0, -1, %0" : "=v"(l2));
          E(acc, cur, wr, wc, l2 & 15, l2 >> 4); }
        if (!has_next) break;
#pragma unroll
        for (int a = 0; a < 2; ++a)
#pragma unroll
            for (int b = 0; b < 2; ++b)
#pragma unroll
                for (int m = 0; m < 4; ++m)
#pragma unroll
                    for (int n = 0; n < 2; ++n) acc[a][b][m][n] = (f32x4){0.f, 0.f, 0.f, 0.f};
        cur = nxt; cA = nA; cB = nB; ++ui;
    }
    PG8_WAIT_V(0);
    if (wr == 0) PG8_BAR;
    PG8_BAR;
#undef PG8_SA
#undef PG8_SB
#undef PG8_STAGE
#undef PG8_LDA
#undef PG8_LDB
#undef PG8_MMA
#undef PG8_WAIT_V
#undef PG8_WAIT_L
#undef PG8_BAR
#undef PG8_SCHED
}

struct EpiStore {
    static constexpr bool PERM = true;
    bf16_t* O; int ldc;
    __device__ __forceinline__ void operator()(const f32x4 (&acc)[2][2][4][2], const Unit& u, int wr, int wc, int fr, int fq) const {
        const int row0 = u.pm * BM + wr * 64 + fr, col0 = u.pn * BM + wc * 32 + 8 * fq;
#pragma unroll
        for (int ai = 0; ai < 2; ++ai)
#pragma unroll
            for (int m = 0; m < 4; ++m) { bf16_t* rowp = O + (size_t)(row0 + ai * HALF + m * 16) * ldc + col0;
#pragma unroll
                for (int bj = 0; bj < 2; ++bj) { const f32x4 v0 = acc[ai][bj][m][0], v1 = acc[ai][bj][m][1];
                    u32x4 w; w.x = cvtpk(v0[0], v0[1]); w.y = cvtpk(v0[2], v0[3]); w.z = cvtpk(v1[0], v1[1]); w.w = cvtpk(v1[2], v1[3]);
                    *(u32x4*)(rowp + bj * HALF) = w; } }
    }
};
struct EpiU {
    static constexpr bool PERM = true;
    bf16_t* U; float* SSQ; float* SSKV; float* SSKR;
    __device__ __forceinline__ void operator()(const f32x4 (&acc)[2][2][4][2], const Unit& u, int wr, int wc, int fr, int fq) const {
        const int row0 = u.pm * BM + wr * 64 + fr, col0 = u.pn * BM + wc * 32 + 8 * fq;
#pragma unroll
        for (int ai = 0; ai < 2; ++ai)
#pragma unroll
            for (int m = 0; m < 4; ++m) { const int row = row0 + ai * HALF + m * 16; bf16_t* rowp = U + (size_t)row * NINP + col0; float ss[2];
#pragma unroll
                for (int bj = 0; bj < 2; ++bj) { const f32x4 v0 = acc[ai][bj][m][0], v1 = acc[ai][bj][m][1];
                    u32x4 w; w.x = cvtpk(v0[0], v0[1]); w.y = cvtpk(v0[2], v0[3]); w.z = cvtpk(v1[0], v1[1]); w.w = cvtpk(v1[2], v1[3]);
                    *(u32x4*)(rowp + bj * HALF) = w;
                    ss[bj] = v0[0] * v0[0] + v0[1] * v0[1] + v0[2] * v0[2] + v0[3] * v0[3] + v1[0] * v1[0] + v1[1] * v1[1] + v1[2] * v1[2] + v1[3] * v1[3]; }
                if (u.pn <= 1) {
                    float s0 = ss[0], s1 = ss[1];
                    s0 += __shfl_xor(s0, 16); s0 += __shfl_xor(s0, 32); s1 += __shfl_xor(s1, 16); s1 += __shfl_xor(s1, 32);
                    if (fq == 0) {
                        if (u.pn == 0) SSQ[(size_t)row * 4 + wc] = s0 + s1;
                        else { SSKV[(size_t)row * 4 + wc] = s0; if (wc < 2) SSKR[(size_t)row * 4 + wc] = s1; }
                    }
                }
            }
    }
};
struct EpiKV {
    static constexpr bool PERM = true;
    char* KIMG; bf16_t* V; const bf16_t* U; const float* SSKV; const float* SSKR; const float* kg; const float* ROPEC; LAS float* part;
    __device__ __forceinline__ void operator()(const f32x4 (&acc)[2][2][4][2], const Unit& u, int wr, int wc, int fr, int fq) const {
        const int row0 = u.pm * BM + wr * 64 + fr, col0 = wc * 32 + 8 * fq, h = u.pn;
        const int b = (u.pm * BM) / LK; const int jbase = u.pm * BM - b * LK; const bool lat = jbase != 0;
        LAS float* mine = part + (wr * 4 + wc) * 128;
        float rs[8];
#pragma unroll
        for (int ai = 0; ai < 2; ++ai) {
            f32x4 s4[4]; float kr2[4];
#pragma unroll
            for (int m = 0; m < 4; ++m) { const size_t ro = (size_t)(row0 + ai * HALF + m * 16) * 4; s4[m] = *(const f32x4*)(SSKV + ro); const float2 t = *(const float2*)(SSKR + ro); kr2[m] = t.x + t.y; }
#pragma unroll
            for (int m = 0; m < 4; ++m) { const f32x4 q4 = s4[m]; const float r1 = rsqrtf((q4[0] + q4[1] + q4[2] + q4[3]) * (1.f / 128.f) + EPS); rs[ai * 4 + m] = r1;
                const f32x4 v0 = acc[ai][0][m][0], v1 = acc[ai][0][m][1];
                float ss = v0[0] * v0[0] + v0[1] * v0[1] + v0[2] * v0[2] + v0[3] * v0[3] + v1[0] * v1[0] + v1[1] * v1[1] + v1[2] * v1[2] + v1[3] * v1[3];
                ss *= r1 * r1;
                ss += __shfl_xor(ss, 16); ss += __shfl_xor(ss, 32);
                if (wc == 0) ss += kr2[m];
                if (fq == 0) mine[(ai * 4 + m) * 16 + fr] = ss; } }
        asm volatile("s_waitcnt lgkmcnt(0)" ::: "memory"); __builtin_amdgcn_s_barrier(); asm volatile("" ::: "memory");
        float rk[8];
#pragma unroll
        for (int i8 = 0; i8 < 8; ++i8) { const int o = i8 * 16 + fr; LAS float* pr = part + wr * 4 * 128;
            rk[i8] = rsqrtf((pr[o] + pr[128 + o] + pr[256 + o] + pr[384 + o]) * (1.f / 192.f) + EPS); }
        const int cn = 4 * wc + fq; const f32x4 gn0 = *(const f32x4*)(kg + cn * 8), gn1 = *(const f32x4*)(kg + cn * 8 + 4);
        const int cr = (4 * wc + fq) & 7, q = fq; const bool first = q < 2; const int cp = first ? cr + 2 : cr - 2;
        const f32x4 ga0 = *(const f32x4*)(kg + 128 + cr * 8), ga1 = *(const f32x4*)(kg + 128 + cr * 8 + 4), gb0 = *(const f32x4*)(kg + 128 + cp * 8), gb1 = *(const f32x4*)(kg + 128 + cp * 8 + 4);
        __builtin_amdgcn_sched_barrier(0);
#pragma unroll
        for (int ai = 0; ai < 2; ++ai)
#pragma unroll
            for (int m = 0; m < 4; ++m) { const int i8 = ai * 4 + m; const float rr = rs[i8] * rk[i8];
                const int tile = (jbase >> 6) + ai * 2 + wr, kk = m * 16 + fr, j = jbase + ai * HALF + wr * 64 + kk;
                char* img = KIMG + ((size_t)(b * NH + h) * NTILE + tile) * KIMG_B + ((kk >> 5) * 64 + (kk & 31)) * 16;
                { const f32x4 v0 = acc[ai][0][m][0], v1 = acc[ai][0][m][1]; float o[8];
#pragma unroll
                  for (int e = 0; e < 4; ++e) { o[e] = v0[e] * rr * gn0[e]; o[4 + e] = v1[e] * rr * gn1[e]; }
                  *(u32x4*)(img + ((cn >> 1) * 128 + (cn & 1) * 32) * 16) = pack8(o); }
                { const f32x4 v0 = acc[ai][1][m][0] * rs[i8], v1 = acc[ai][1][m][1] * rs[i8];
                  u32x4 w; w.x = cvtpk(v0[0], v0[1]); w.y = cvtpk(v0[2], v0[3]); w.z = cvtpk(v1[0], v1[1]); w.w = cvtpk(v1[2], v1[3]);
                  *(u32x4*)(V + ((size_t)(b * NH + h) * LK + j) * 128 + col0) = w; } }
        __builtin_amdgcn_sched_barrier(0);
        if (wc < 2) {
#pragma unroll
            for (int pr2 = 0; pr2 < 4; ++pr2) {
                u32x4 xa[2], xb[2]; f32x4 c0[2], c1[2], s0[2], s1[2];
#pragma unroll
                for (int t = 0; t < 2; ++t) { const int i8 = pr2 * 2 + t, ai = i8 >> 2, m = i8 & 3; const int row = row0 + ai * HALF + m * 16;
                    const int kk = m * 16 + fr, j = jbase + ai * HALF + wr * 64 + kk; const int pos = j - CL; const int posi = lat ? (wc == 0 ? (pos >> 6) : (pos & 63)) : 0;
                    const bf16_t* krrow = U + (size_t)row * NINP + OFF_KR;
                    xa[t] = *(const u32x4*)(krrow + cr * 8); xb[t] = *(const u32x4*)(krrow + cp * 8);
                    c0[t] = *(const f32x4*)(ROPEC + posi * 16 + (q & 1) * 8); c1[t] = *(const f32x4*)(ROPEC + posi * 16 + (q & 1) * 8 + 4);
                    s0[t] = *(const f32x4*)(ROPEC + 1024 + posi * 16 + (q & 1) * 8); s1[t] = *(const f32x4*)(ROPEC + 1024 + posi * 16 + (q & 1) * 8 + 4); }
                __builtin_amdgcn_sched_barrier(0);
#pragma unroll
                for (int t = 0; t < 2; ++t) { const int i8 = pr2 * 2 + t, ai = i8 >> 2, m = i8 & 3;
                    const int tile = (jbase >> 6) + ai * 2 + wr, kk = m * 16 + fr;
                    char* img = KIMG + ((size_t)(b * NH + h) * NTILE + tile) * KIMG_B + ((kk >> 5) * 64 + (kk & 31)) * 16;
                    float fa[8], fb[8], o[8]; unpack8(xa[t], fa); unpack8(xb[t], fb);
#pragma unroll
                    for (int e = 0; e < 8; ++e) { const float a = fa[e] * rk[i8] * ((e < 4) ? ga0[e & 3] : ga1[e & 3]), pn = fb[e] * rk[i8] * ((e < 4) ? gb0[e & 3] : gb1[e & 3]);
                        const float cs = lat ? ((e < 4) ? c0[t][e & 3] : c1[t][e & 3]) : 1.f, sn = lat ? ((e < 4) ? s0[t][e & 3] : s1[t][e & 3]) : 0.f;
                        o[e] = first ? (a * cs - pn * sn) : (a * cs + pn * sn); }
                    const int c = 16 + cr; *(u32x4*)(img + ((c >> 1) * 128 + (c & 1) * 32) * 16) = pack8(o); }
                __builtin_amdgcn_sched_barrier(0); }
        }
    }
};
struct EpiOut {
    static constexpr bool PERM = false;
    float* out; const float* x; const float* MOD;
    __device__ __forceinline__ void operator()(const f32x4 (&acc)[2][2][4][2], const Unit& u, int wr, int wc, int fr, int fq) const {
        const int row0 = u.pm * BM + wr * 64 + fr, col0 = u.pn * BM + wc * 32 + 4 * fq;
        const int b = (u.pm * BM) >> 12;
        f32x4 gv[2][2];
#pragma unroll
        for (int bj = 0; bj < 2; ++bj)
#pragma unroll
            for (int n = 0; n < 2; ++n) gv[bj][n] = *(const f32x4*)(MOD + b * 3072 + 2048 + col0 + bj * HALF + n * 16);
        f32x4 xv[2][2][2][2];
#define EPO_LOAD(K) do { const int ai_ = (K) >> 1, mh_ = (K) & 1; _Pragma("unroll") for (int mm = 0; mm < 2; ++mm) { const size_t ro = (size_t)(row0 + ai_ * HALF + (mh_ * 2 + mm) * 16) * 1024 + col0; \
        _Pragma("unroll") for (int bj = 0; bj < 2; ++bj) _Pragma("unroll") for (int n = 0; n < 2; ++n) xv[(K) & 1][mm][bj][n] = *(const f32x4*)(x + ro + bj * HALF + n * 16); } } while (0)
#define EPO_STORE(K) do { const int ai_ = (K) >> 1, mh_ = (K) & 1; _Pragma("unroll") for (int mm = 0; mm < 2; ++mm) { const size_t ro = (size_t)(row0 + ai_ * HALF + (mh_ * 2 + mm) * 16) * 1024 + col0; \
        _Pragma("unroll") for (int bj = 0; bj < 2; ++bj) _Pragma("unroll") for (int n = 0; n < 2; ++n) *(f32x4*)(out + ro + bj * HALF + n * 16) = xv[(K) & 1][mm][bj][n] + gv[bj][n] * acc[ai_][bj][mh_ * 2 + mm][n]; } } while (0)
        EPO_LOAD(0); __builtin_amdgcn_sched_barrier(0);
        EPO_LOAD(1); __builtin_amdgcn_sched_barrier(0); EPO_STORE(0); __builtin_amdgcn_sched_barrier(0);
        EPO_LOAD(2); __builtin_amdgcn_sched_barrier(0); EPO_STORE(1); __builtin_amdgcn_sched_barrier(0);
        EPO_LOAD(3); __builtin_amdgcn_sched_barrier(0); EPO_STORE(2); __builtin_amdgcn_sched_barrier(0);
        EPO_STORE(3);
#undef EPO_LOAD
#undef EPO_STORE
    }
};
}

constexpr int NW = 8, QBLK = 32, KVBLK = 64;
constexpr float SCALE = 0.07216878364870323f;
constexpr float THR = 8.f;
constexpr int SDEPTH = 1;
constexpr int SHM_V = KVBLK * DV * 2, SHM_K = KIMG_B, SHM_ATTN = 2 * SHM_V + 2 * SHM_K + NW * 64 * 4;
#define SBAR() __builtin_amdgcn_sched_barrier(0)
__device__ __forceinline__ int crow(int r, int hi) { return (r & 3) + 8 * (r >> 2) + 4 * hi; }

__device__ __forceinline__ void partialSM(f32x16& p0, f32x16& p1, float& m_reg, float& mn, float& alpha) {
    constexpr float C = SCALE * 1.4426950408889634f;
    float pmax = p0[0];
#pragma unroll
    for (int r = 1; r < 16; ++r) pmax = fmaxf(pmax, p0[r]);
#pragma unroll
    for (int r = 0; r < 16; ++r) pmax = fmaxf(pmax, p1[r]);
    { auto rr = __builtin_amdgcn_permlane32_swap(__float_as_uint(pmax), __float_as_uint(pmax), false, false);
      pmax = fmaxf(__uint_as_float(rr[0]), __uint_as_float(rr[1])); }
    if (__builtin_expect(__all(pmax - m_reg <= THR / SCALE), 1)) { mn = m_reg; alpha = 1.f; }
    else { mn = fmaxf(m_reg, pmax); alpha = __builtin_amdgcn_exp2f((m_reg - mn) * C); m_reg = mn; }
    const float mnC = -mn * C;
#pragma unroll
    for (int r = 0; r < 16; ++r) p0[r] = fmaf(p0[r], C, mnC);
#pragma unroll
    for (int r = 0; r < 16; ++r) p1[r] = fmaf(p1[r], C, mnC);
#pragma unroll
    for (int r = 0; r < 16; ++r) p0[r] = __builtin_amdgcn_exp2f(p0[r]);
}
__device__ __forceinline__ void finishSM(f32x16& p0, f32x16& p1, float alpha, float& l_reg, bf16x8& pa0, bf16x8& pa1, bf16x8& pa2, bf16x8& pa3) {
#pragma unroll
    for (int r = 0; r < 16; ++r) p1[r] = __builtin_amdgcn_exp2f(p1[r]);
    float ps = 0;
#pragma unroll
    for (int r = 0; r < 16; ++r) ps += p0[r];
#pragma unroll
    for (int r = 0; r < 16; ++r) ps += p1[r];
    { auto rr = __builtin_amdgcn_permlane32_swap(__float_as_uint(ps), __float_as_uint(ps), false, false);
      ps = __uint_as_float(rr[0]) + __uint_as_float(rr[1]); }
    l_reg = l_reg * alpha + ps;
#define PK4(P, BASE, OUT) do { unsigned a0 = cvtpk(P[BASE + 0], P[BASE + 1]), a1 = cvtpk(P[BASE + 2], P[BASE + 3]);   \
    unsigned b0 = cvtpk(P[BASE + 4], P[BASE + 5]), b1 = cvtpk(P[BASE + 6], P[BASE + 7]);                              \
    auto r0 = __builtin_amdgcn_permlane32_swap(a0, b0, false, false); auto r1 = __builtin_amdgcn_permlane32_swap(a1, b1, false, false); \
    u32x4 w = {r0[0], r1[0], r0[1], r1[1]}; OUT = *reinterpret_cast<bf16x8*>(&w); } while (0)
    PK4(p0, 0, pa0); PK4(p0, 8, pa1); PK4(p1, 0, pa2); PK4(p1, 8, pa3);
#undef PK4
}
__device__ __forceinline__ void qkt(f32x16& p0, f32x16& p1, const char* Ks, const bf16x8* qr, int lane) {
    p0 = f32x16{}; p1 = f32x16{};
#pragma unroll
    for (int d0 = 0; d0 < 12; ++d0) {
        const bf16x8 b0 = *reinterpret_cast<const bf16x8*>(Ks + lane * 16 + d0 * 2048);
        const bf16x8 b1 = *reinterpret_cast<const bf16x8*>(Ks + lane * 16 + d0 * 2048 + 1024);
        p0 = __builtin_amdgcn_mfma_f32_32x32x16_bf16(b0, qr[d0], p0, 0, 0, 0);
        p1 = __builtin_amdgcn_mfma_f32_32x32x16_bf16(b1, qr[d0], p1, 0, 0, 0); }
}
__device__ __forceinline__ int v_st(int k, int c) { const int kk = (k & ~0xC) | ((k & 4) << 1) | ((k & 8) >> 1); return ((kk >> 3) * 4 + (c >> 5)) * 512 + ((kk & 7) * 32 + (c & 31)) * 2; }
__device__ __forceinline__ int v_rd_base(int lane) { return ((lane & 3) << 3) | (((lane >> 2) & 3) << 6) | (((lane >> 4) & 1) << 5) | (((lane >> 5) & 1) << 8); }
constexpr int v_rd_off(int d0, int ks, int half) { return d0 * 512 + ks * 4096 + half * 2048; }
template <int OFF> __device__ __forceinline__ s16x4 tr_read(int vb) {
    s16x4 r; asm volatile("ds_read_b64_tr_b16 %0, %1 offset:%2" : "=&v"(r) : "v"(vb), "i"(OFF) : "memory"); return r;
}
template <int D0> __device__ __forceinline__ void pv_one(f32x16& od, int vb, bf16x8 pa0, bf16x8 pa1, bf16x8 pa2, bf16x8 pa3) {
    const s16x4 l0 = tr_read<v_rd_off(D0, 0, 0)>(vb), h0 = tr_read<v_rd_off(D0, 0, 1)>(vb), l1 = tr_read<v_rd_off(D0, 1, 0)>(vb), h1 = tr_read<v_rd_off(D0, 1, 1)>(vb);
    const s16x4 l2 = tr_read<v_rd_off(D0, 2, 0)>(vb), h2 = tr_read<v_rd_off(D0, 2, 1)>(vb), l3 = tr_read<v_rd_off(D0, 3, 0)>(vb), h3 = tr_read<v_rd_off(D0, 3, 1)>(vb);
    asm volatile("s_waitcnt lgkmcnt(0)" ::: "memory"); SBAR();
#define PK(L, H) (bf16x8){L[0], L[1], L[2], L[3], H[0], H[1], H[2], H[3]}
    od = __builtin_amdgcn_mfma_f32_32x32x16_bf16(pa0, PK(l0, h0), od, 0, 0, 0);
    od = __builtin_amdgcn_mfma_f32_32x32x16_bf16(pa1, PK(l1, h1), od, 0, 0, 0);
    od = __builtin_amdgcn_mfma_f32_32x32x16_bf16(pa2, PK(l2, h2), od, 0, 0, 0);
    od = __builtin_amdgcn_mfma_f32_32x32x16_bf16(pa3, PK(l3, h3), od, 0, 0, 0);
#undef PK
}
__device__ __forceinline__ void pv_d0(f32x16* o, int vb, bf16x8 pa0, bf16x8 pa1, bf16x8 pa2, bf16x8 pa3) {
    pv_one<0>(o[0], vb, pa0, pa1, pa2, pa3); pv_one<1>(o[1], vb, pa0, pa1, pa2, pa3); pv_one<2>(o[2], vb, pa0, pa1, pa2, pa3); pv_one<3>(o[3], vb, pa0, pa1, pa2, pa3);
}

__device__ __forceinline__ void attn_item(const Params& p, int b, int h, int qb, char* lds, int wv) {
    const bf16_t* QRAW = (const bf16_t*)(p.ws + WS_QRAW); const bf16_t* U = (const bf16_t*)(p.ws + WS_U); const float* SSQ = (const float*)(p.ws + WS_SSQ);
    const float* ROPEC = (const float*)(p.ws + WS_ROPE); const float* ROPES = ROPEC + 1024;
    const char* Kimg = (const char*)(p.ws + WS_KIMG) + (size_t)(b * NH + h) * NTILE * KIMG_B;
    const bf16_t* Vh = (const bf16_t*)(p.ws + WS_V) + (size_t)(b * NH + h) * LK * 128;
    bf16_t* BR = (bf16_t*)(p.ws + WS_BR);
    const int tid = fresh_tid(wv), wid = tid >> 6, lane = tid & 63, r32 = lane & 31, hi = lane >> 5;
    char* V_lds = lds; char* K_lds = lds + 2 * SHM_V;
    float* wsl = (float*)(lds + 2 * SHM_V + 2 * SHM_K) + wid * 64; float* li_l = wsl; float* al_l = wsl + 32;
    float m_reg = -1e30f, l_reg = 0; f32x16 o[4] = {}; bf16x8 qr[12];
    const int pos = qb * 256 + wid * QBLK + r32;
    const size_t urow = (size_t)b * LK + CL + pos;
    {
        const bf16_t* qp = QRAW + urow * 768 + h * DQK + hi * 8;
        u32x4 raw[12];
#pragma unroll
        for (int d0 = 0; d0 < 12; ++d0) raw[d0] = *(const u32x4*)(qp + d0 * 16);
        const f32x4 s4 = *(const f32x4*)(SSQ + urow * 4);
        const float rstd_q = rsqrtf((s4[0] + s4[1] + s4[2] + s4[3]) * (1.f / 256.f) + EPS);
        float ss = 0.f;
#pragma unroll
        for (int d0 = 0; d0 < 12; ++d0) { float t[8]; unpack8(raw[d0], t);
#pragma unroll
            for (int e = 0; e < 8; ++e) { const float v = t[e] * rstd_q; ss += v * v; } }
        { auto rr = __builtin_amdgcn_permlane32_swap(__float_as_uint(ss), __float_as_uint(ss), false, false); ss = __uint_as_float(rr[0]) + __uint_as_float(rr[1]); }
        SBAR();
        const float rq = rsqrtf(ss * (1.f / 192.f) + EPS) * rstd_q;
        const int prow = pos >> 6, pcol = pos & 63;
#pragma unroll
        for (int d0 = 0; d0 < 8; ++d0) { float t[8]; unpack8(raw[d0], t);
            const f32x4 g0 = *(const f32x4*)(p.q_norm_g + d0 * 16 + hi * 8), g1 = *(const f32x4*)(p.q_norm_g + d0 * 16 + hi * 8 + 4);
#pragma unroll
            for (int e = 0; e < 4; ++e) { t[e] *= rq * g0[e]; t[4 + e] *= rq * g1[e]; }
            const u32x4 w = pack8(t); qr[d0] = *reinterpret_cast<const bf16x8*>(&w); SBAR(); }
#pragma unroll
        for (int pr = 0; pr < 2; ++pr) { const int da = 8 + 2 * pr, db = da + 1; float ta[8], tb[8]; unpack8(raw[da], ta); unpack8(raw[db], tb);
            const f32x4 ga0 = *(const f32x4*)(p.q_norm_g + da * 16 + hi * 8), ga1 = *(const f32x4*)(p.q_norm_g + da * 16 + hi * 8 + 4);
            const f32x4 gb0 = *(const f32x4*)(p.q_norm_g + db * 16 + hi * 8), gb1 = *(const f32x4*)(p.q_norm_g + db * 16 + hi * 8 + 4);
            const int pp = pr ? pcol : prow;
#pragma unroll
            for (int e = 0; e < 8; ++e) { const float ga = (e < 4) ? ga0[e & 3] : ga1[e & 3], gb = (e < 4) ? gb0[e & 3] : gb1[e & 3];
                const float a = ta[e] * rq * ga, bb = tb[e] * rq * gb; const int fi = hi * 8 + e;
                const float cs = ROPEC[pp * 16 + fi], sn = ROPES[pp * 16 + fi];
                ta[e] = a * cs - bb * sn; tb[e] = bb * cs + a * sn; }
            const u32x4 wa = pack8(ta), wb = pack8(tb); qr[da] = *reinterpret_cast<const bf16x8*>(&wa); qr[db] = *reinterpret_cast<const bf16x8*>(&wb); }
    }
    const int sr = tid >> 4, sc = (tid & 15) * 8, vst0 = v_st(sr, sc), vst1 = v_st(32 + sr, sc);
    const int vb0 = (int)(uintptr_t)V_lds + v_rd_base(lane);
    struct { bf16x8 vs0, vs1, ks0, ks1, ks2; } sr_[SDEPTH];
#define SLOAD(i, t) do { const size_t k0_ = (size_t)(t) * KVBLK; \
    sr_[i].vs0 = *(const bf16x8*)(Vh + (k0_ + sr) * 128 + sc); sr_[i].vs1 = *(const bf16x8*)(Vh + (k0_ + 32 + sr) * 128 + sc); \
    const char* kp_ = Kimg + (size_t)(t) * KIMG_B + tid * 16; \
    sr_[i].ks0 = *(const bf16x8*)(kp_); sr_[i].ks1 = *(const bf16x8*)(kp_ + 8192); sr_[i].ks2 = *(const bf16x8*)(kp_ + 16384); } while (0)
#define SWRITE(bu, i) do { *(bf16x8*)(V_lds + (bu) * SHM_V + vst0) = sr_[i].vs0; *(bf16x8*)(V_lds + (bu) * SHM_V + vst1) = sr_[i].vs1; \
    char* kd_ = K_lds + (bu) * SHM_K + tid * 16; *(bf16x8*)(kd_) = sr_[i].ks0; *(bf16x8*)(kd_ + 8192) = sr_[i].ks1; *(bf16x8*)(kd_ + 16384) = sr_[i].ks2; } while (0)
#define SWAIT() do { if constexpr (SDEPTH == 2) asm volatile("s_waitcnt vmcnt(5)" ::: "memory"); else asm volatile("s_waitcnt vmcnt(0)" ::: "memory"); } while (0)
#define RESC(a) do { if (__any((a) < 1.f)) { if (hi == 0) al_l[r32] = (a); asm volatile("s_waitcnt lgkmcnt(0)" ::: "memory"); \
    _Pragma("unroll") for (int d = 0; d < 4; ++d) _Pragma("unroll") for (int r = 0; r < 16; ++r) o[d][r] *= al_l[crow(r, hi)]; } } while (0)
    f32x16 pA0, pA1, pB0, pB1; float mnA, mnB, alA, alB; bf16x8 pa0, pa1, pa2, pa3; constexpr int NT = NTILE;
    constexpr int SE = 0, SO = SDEPTH - 1;
    SLOAD(SE, 0); asm volatile("s_waitcnt vmcnt(0)" ::: "memory"); SWRITE(0, SE); __syncthreads();
    qkt(pA0, pA1, K_lds, qr, lane); partialSM(pA0, pA1, m_reg, mnA, alA);
    SLOAD(SO, 1); if constexpr (SDEPTH == 2) { SLOAD(SE, 2); }
    SWAIT(); SWRITE(1, SO); __syncthreads();
    for (int j = 1; j + 1 < NT; j += 2) {
        SBAR(); qkt(pB0, pB1, K_lds + SHM_K, qr, lane);
        finishSM(pA0, pA1, alA, l_reg, pa0, pa1, pa2, pa3); SBAR();
        SLOAD(SO, j + SDEPTH); SBAR();
        pv_d0(o, vb0, pa0, pa1, pa2, pa3); partialSM(pB0, pB1, m_reg, mnB, alB);
        __syncthreads(); SWAIT(); SWRITE(0, SE);
        RESC(alB); __syncthreads();
        SBAR(); qkt(pA0, pA1, K_lds, qr, lane);
        finishSM(pB0, pB1, alB, l_reg, pa0, pa1, pa2, pa3); SBAR();
        if (SDEPTH == 1 || j + 3 < NT) SLOAD(SE, j + 1 + SDEPTH); SBAR();
        pv_d0(o, vb0 + SHM_V, pa0, pa1, pa2, pa3); partialSM(pA0, pA1, m_reg, mnA, alA);
        __syncthreads(); SWAIT(); SWRITE(1, SO);
        RESC(alA); __syncthreads();
    }
    SBAR(); qkt(pB0, pB1, K_lds + SHM_K, qr, lane);
    finishSM(pA0, pA1, alA, l_reg, pa0, pa1, pa2, pa3); SBAR();
    pv_d0(o, vb0, pa0, pa1, pa2, pa3); partialSM(pB0, pB1, m_reg, mnB, alB);
    __syncthreads(); RESC(alB);
    finishSM(pB0, pB1, alB, l_reg, pa0, pa1, pa2, pa3); SBAR();
    pv_d0(o, vb0 + SHM_V, pa0, pa1, pa2, pa3);
    if (hi == 0) li_l[r32] = l_reg; asm volatile("s_waitcnt lgkmcnt(0)" ::: "memory");
    float rli[16];
#pragma unroll
    for (int r = 0; r < 16; ++r) rli[r] = __builtin_amdgcn_rcpf(li_l[crow(r, hi)]);
    const int posw = qb * 256 + wid * QBLK;
    unsigned short gts[16][4];
#pragma unroll
    for (int r = 0; r < 16; ++r) { const int qpos = posw + crow(r, hi); const int orow = (qpos & 127) * 32 + (qpos >> 7);
        const bf16_t* gp = U + ((size_t)b * LK + CL + orow) * NINP + OFF_GA + h * 128 + r32;
#pragma unroll
        for (int d0 = 0; d0 < 4; ++d0) gts[r][d0] = gp[d0 * 32]; }
    SBAR();
#pragma unroll
    for (int r = 0; r < 16; ++r) { const int qpos = posw + crow(r, hi);
        const int orow = (qpos & 127) * 32 + (qpos >> 7);
        bf16_t* op = BR + ((size_t)b * SEQ + orow) * 1024 + h * 128 + r32;
#pragma unroll
        for (int d0 = 0; d0 < 4; ++d0) { const float g = bf2f(gts[r][d0]); op[d0 * 32] = f2bf(silu_f(g) * o[d0][r] * rli[r]); } }
#undef SLOAD
#undef SWRITE
#undef SWAIT
#undef RESC
}

__device__ __forceinline__ void phase_mod(const Params& p, char* lds, int wv) {
    float* MOD = (float*)(p.ws + WS_MOD);
    float* sc = (float*)lds;
    float* part = sc + 9 * 1024;
    const int tid = fresh_tid(wv);
    { float cv[18];
#pragma unroll
      for (int q = 0; q < 18; ++q) { const int i = tid + q * 512; const int r = i >> 10, k = i & 1023; cv[q] = (r < 8) ? p.c[r * 1024 + k] : p.c_ctx[k]; }
      __builtin_amdgcn_sched_barrier(0);
#pragma unroll
      for (int q = 0; q < 18; ++q) sc[tid + q * 512] = silu_f(cv[q]); }
    __syncthreads();
    const int cl = tid & 31, kg = tid >> 5, col = blockIdx.x * 32 + cl;
    float acc[9];
#pragma unroll
    for (int r = 0; r < 9; ++r) acc[r] = 0.f;
#pragma unroll
    for (int kb = 0; kb < 64; kb += 32) { float w[32];
#pragma unroll
        for (int q = 0; q < 32; ++q) w[q] = p.w_mod[(size_t)(kg * 64 + kb + q) * 3072 + col];
        __builtin_amdgcn_sched_barrier(0);
#pragma unroll
        for (int q = 0; q < 32; ++q) { const int k = kg * 64 + kb + q;
#pragma unroll
            for (int r = 0; r < 9; ++r) acc[r] += sc[r * 1024 + k] * w[q]; } }
#pragma unroll
    for (int r = 0; r < 9; ++r) part[(kg * 9 + r) * 32 + cl] = acc[r];
    __syncthreads();
    if (tid < 288) { const int r = tid >> 5, c2 = tid & 31; float s = 0.f;
        for (int g = 0; g < 16; ++g) s += part[(g * 9 + r) * 32 + c2];
        const int n = blockIdx.x * 32 + c2; MOD[r * 3072 + n] = s + p.b_mod[n]; }
    __syncthreads();
}
__device__ __forceinline__ void phase_weights(const Params& p, char* lds, int wv, int part, int b0) {
    bf16_t* WinT = (bf16_t*)(p.ws + WS_WIN); bf16_t* WuqT = (bf16_t*)(p.ws + WS_WUQ); bf16_t* WukvT = (bf16_t*)(p.ws + WS_WUKV);
    bf16_t* WoutT = (bf16_t*)(p.ws + WS_WOUT);
    constexpr long C0 = 128L * 2048, C1 = C0 + 32L * 768, C2 = C1 + 16L * 1024, C3 = C2 + 128L * 1024, C4 = C3;
    const int tid = fresh_tid(wv);
    const long itLo = part ? C0 : 0, itHi = part ? C4 : C0; const int nbw = (int)gridDim.x - b0;
    for (long it = itLo + ((long)blockIdx.x - b0) * 512 + tid; it < itHi && (int)blockIdx.x >= b0; it += (long)nbw * 512) {
        float v[8]; bf16_t* dst;
        if (it < C0) { const int n = (int)(it % 2048), k8 = (int)(it / 2048);
#pragma unroll
            for (int e = 0; e < 8; ++e) v[e] = p.w_in[(size_t)(k8 * 8 + e) * 1984 + (n < 1984 ? n : 1983)];
            if (n >= 1984) {
#pragma unroll
                for (int e = 0; e < 8; ++e) v[e] = 0.f; }
            if (n >= OFF_PIN && n < OFF_GP) continue;
            dst = WinT + (size_t)n * 1024 + k8 * 8; }
        else if (it < C1) { const long i2 = it - C0; const int n = (int)(i2 % 768), k8 = (int)(i2 / 768);
#pragma unroll
            for (int e = 0; e < 8; ++e) v[e] = p.w_uq[(size_t)(k8 * 8 + e) * 768 + n] * p.q_lora_g[k8 * 8 + e];
            dst = WuqT + (size_t)n * 256 + k8 * 8; }
        else if (it < C2) { const long i2 = it - C1; const int n = (int)(i2 % 1024), k8 = (int)(i2 / 1024);
#pragma unroll
            for (int e = 0; e < 8; ++e) v[e] = p.w_ukv[(size_t)(k8 * 8 + e) * 1024 + n] * p.kv_lora_g[k8 * 8 + e];
            dst = WukvT + (size_t)n * 128 + k8 * 8; }
        else { const long i2 = it - C2; const int n = (int)(i2 % 1024), k8 = (int)(i2 / 1024);
#pragma unroll
            for (int e = 0; e < 8; ++e) v[e] = p.w_out[(size_t)(k8 * 8 + e) * 1024 + n];
            dst = WoutT + (size_t)n * 1024 + k8 * 8; }
        *(u32x4*)dst = pack8(v);
    }
    if (part == 0) {   float* wpS = (float*)lds; float* wiS = wpS + 128 * 128;
        for (int item = gridDim.x - 1 - blockIdx.x; item < 4 * 32; item += gridDim.x) {
            const int g = item >> 5, k0 = (item & 31) * 32;
            __syncthreads();
            for (int i = tid; i < 128 * 128 / 4; i += 512) *(f32x4*)(wpS + i * 4) = *(const f32x4*)(p.w_pool + (size_t)g * 128 * 128 + i * 4);
            for (int i = tid; i < 32 * 128 / 4; i += 512) { const int kk = i >> 5, c4 = (i & 31) * 4; *(f32x4*)(wiS + kk * 128 + c4) = *(const f32x4*)(p.w_in + (size_t)(k0 + kk) * 1984 + OFF_PIN + g * 128 + c4); }
            __syncthreads();
            const int d = tid & 127, kq = tid >> 7;
            float v[8];
#pragma unroll
            for (int e = 0; e < 8; ++e) v[e] = 0.f;
            for (int c = 0; c < 128; c += 4) { float wq[4];
#pragma unroll
                for (int q = 0; q < 4; ++q) wq[q] = wpS[(c + q) * 128 + d];
#pragma unroll
                for (int e = 0; e < 8; ++e) { const f32x4 a = *(const f32x4*)(wiS + (kq * 8 + e) * 128 + c); v[e] += a[0] * wq[0] + a[1] * wq[1] + a[2] * wq[2] + a[3] * wq[3]; } }
            *(u32x4*)(WinT + (size_t)(OFF_PIN + g * 128 + d) * 1024 + k0 + kq * 8) = pack8(v);
        }
        __syncthreads();
    }
    if (part == 0 && blockIdx.x == gridDim.x - 1) {
        float* ROPEC = (float*)(p.ws + WS_ROPE); float* ROPES = ROPEC + 1024;
        for (int i = tid; i < 1024; i += 512) { const int pos = i >> 4, f = i & 15;
            const float inv = exp2f(-(float)f * (13.287712379549449f / 16.f)); const float ang = (float)pos * inv;
            ROPEC[i] = cosf(ang); ROPES[i] = sinf(ang); }
    }
}
__device__ __forceinline__ void phase_norm(const Params& p, int wv) {
    const float* MOD = (const float*)(p.ws + WS_MOD); bf16_t* H = (bf16_t*)(p.ws + WS_H);
    const int tid = fresh_tid(wv), lane = tid & 63, wid = tid >> 6;
    for (int r = blockIdx.x * 8 + wid; r < MT; r += gridDim.x * 8) {
        const int b = r / LK, j = r - b * LK;
        const float* src = (j < CL) ? p.ctx + ((size_t)b * CL + j) * 1024 : p.x + ((size_t)b * SEQ + (j - CL)) * 1024;
        const float* mrow = MOD + ((j < CL) ? 8 : b) * 3072;
        float v[16]; float ss = 0.f;
#pragma unroll
        for (int i = 0; i < 2; ++i) { const f32x4 a0 = *(const f32x4*)(src + i * 512 + lane * 8), a1 = *(const f32x4*)(src + i * 512 + lane * 8 + 4);
#pragma unroll
            for (int e = 0; e < 4; ++e) { v[i * 8 + e] = a0[e]; v[i * 8 + 4 + e] = a1[e]; } }
#pragma unroll
        for (int e = 0; e < 16; ++e) ss += v[e] * v[e];
#pragma unroll
        for (int s = 1; s < 64; s <<= 1) ss += __shfl_xor(ss, s);
        const float rstd = rsqrtf(ss * (1.f / 1024.f) + EPS);
#pragma unroll
        for (int i = 0; i < 2; ++i) { const int k0 = i * 512 + lane * 8; float o[8];
#pragma unroll
            for (int e4 = 0; e4 < 2; ++e4) { const f32x4 g = *(const f32x4*)(p.norm_g + k0 + e4 * 4), sh = *(const f32x4*)(mrow + k0 + e4 * 4), scl = *(const f32x4*)(mrow + 1024 + k0 + e4 * 4);
#pragma unroll
                for (int e = 0; e < 4; ++e) o[e4 * 4 + e] = v[i * 8 + e4 * 4 + e] * rstd * g[e] * (1.f + scl[e]) + sh[e]; }
            *(u32x4*)(H + (size_t)r * 1024 + k0) = pack8(o); }
    }
}
template <int W>
__device__ __forceinline__ void pooled_item(const bf16_t* __restrict__ Ub, bf16_t* __restrict__ BRb, const float* __restrict__ psc, int g, int t0, int cc) {
    constexpr int NR = W + 3; const int ch = g * 128 + cc * 8;
    u32x4 rows[NR]; u32x4 gts[4];
#pragma unroll
    for (int i = 0; i < NR; ++i) { const int tt = t0 - W / 2 + i; const int tc = tt < 0 ? 0 : (tt >= SEQ ? SEQ - 1 : tt);
        rows[i] = *(const u32x4*)(Ub + (size_t)tc * NINP + OFF_PIN + ch);
        if (tt < 0 || tt >= SEQ) rows[i] = (u32x4){0u, 0u, 0u, 0u}; }
#pragma unroll
    for (int q = 0; q < 4; ++q) gts[q] = *(const u32x4*)(Ub + (size_t)(t0 + q) * NINP + OFF_GP + ch);
    const f32x4 p0 = *(const f32x4*)(psc + ch), p1 = *(const f32x4*)(psc + ch + 4);
    __builtin_amdgcn_sched_barrier(0);
    float s[8];
#pragma unroll
    for (int e = 0; e < 8; ++e) s[e] = 0.f;
#pragma unroll
    for (int i = 0; i < W; ++i) { float f[8]; unpack8(rows[i], f);
#pragma unroll
        for (int e = 0; e < 8; ++e) s[e] += f[e]; }
#pragma unroll
    for (int q = 0; q < 4; ++q) { const int t = t0 + q;
        if (q > 0) { float fo[8], fn[8]; unpack8(rows[q - 1], fo); unpack8(rows[q - 1 + W], fn);
#pragma unroll
            for (int e = 0; e < 8; ++e) s[e] += fn[e] - fo[e]; }
        const int lo = max(t - W / 2, 0), hi = min(t - W / 2 + W, SEQ); const float inv = 1.f / (float)(hi - lo);
        float xt[8]; unpack8(rows[q + W / 2], xt); float gt[8]; unpack8(gts[q], gt); float o[8];
#pragma unroll
        for (int e = 0; e < 8; ++e) o[e] = (s[e] * inv - xt[e]) * silu_f(gt[e]) * ((e < 4) ? p0[e & 3] : p1[e & 3]);
        *(u32x4*)(BRb + (size_t)t * 1024 + 512 + ch) = pack8(o); }
}
__device__ __forceinline__ void phase_pooled(const Params& p, int wv) {
    const bf16_t* U = (const bf16_t*)(p.ws + WS_U); bf16_t* BR = (bf16_t*)(p.ws + WS_BR);
    const int tid = fresh_tid(wv), lane = tid & 63, wid = tid >> 6;
    for (int wi = blockIdx.x * 8 + wid; wi < NB * 4 * (SEQ / 16); wi += gridDim.x * 8) {
        const int rg = wi & 255, g = (wi >> 8) & 3, b = wi >> 10;
        const int t0 = rg * 16 + (lane >> 4) * 4, cc = lane & 15;
        const bf16_t* Ub = U + ((size_t)b * LK + CL) * NINP; bf16_t* BRb = BR + (size_t)b * SEQ * 1024;
        if (g == 0) pooled_item<2>(Ub, BRb, p.pool_scale, g, t0, cc); else if (g == 1) pooled_item<4>(Ub, BRb, p.pool_scale, g, t0, cc);
        else if (g == 2) pooled_item<8>(Ub, BRb, p.pool_scale, g, t0, cc); else pooled_item<16>(Ub, BRb, p.pool_scale, g, t0, cc);
    }
}
#define XB_TMO      128
#define XB_XCNT(j)  (256  + 64 * (j))
#define XB_XSUB(j)  (1280 + 64 * (j))
#define XB_XGEN(j)  (2304 + 64 * (j))
#define XB_TOP      3328
#define XB_TOPGEN   3392
#define XCD_BAR_WORDS 3456
#define XB_SPIN_CAP (1u << 20)
__device__ __forceinline__ unsigned xb_ld(unsigned* p)              { return __hip_atomic_load(p, __ATOMIC_RELAXED, __HIP_MEMORY_SCOPE_AGENT); }
__device__ __forceinline__ unsigned xb_add(unsigned* p, unsigned v) { return __hip_atomic_fetch_add(p, v, __ATOMIC_RELAXED, __HIP_MEMORY_SCOPE_AGENT); }
__device__ __forceinline__ unsigned xb_xcc_id() { return (unsigned)__builtin_amdgcn_s_getreg((3 << 11) | 20) & 0xFu; }
#define XB_SPIN(cond, bar) do { unsigned _sp = 0; while (cond) { __builtin_amdgcn_s_sleep(1); \
    if ((++_sp & 255u) == 0u) { if (xb_ld(&(bar)[XB_TMO])) break; if (_sp > XB_SPIN_CAP) { atomicAdd(&(bar)[XB_TMO], 1u); break; } } } } while (0)
__device__ __forceinline__ void xcd_barrier_complete(unsigned* bar, unsigned x, unsigned& nloc, unsigned& nx) {
    const unsigned G = gridDim.x;
    unsigned sum, cnt, mine, sp = 0u;
    for (;;) {
        sum = 0u; cnt = 0u; mine = 0u;
#pragma unroll
        for (unsigned j = 0; j < 16; ++j) { const unsigned c = xb_ld(&bar[XB_XCNT(j)]); sum += c; cnt += (c > 0u) ? 1u : 0u; mine = (j == x) ? c : mine; }
        if (sum == G) break;
        __builtin_amdgcn_s_sleep(1);
        if ((++sp & 255u) == 0u) { if (xb_ld(&bar[XB_TMO])) break; if (sp > XB_SPIN_CAP) { atomicAdd(&bar[XB_TMO], 1u); break; } }
    }
    nloc = mine > 0u ? mine : 1u; nx = cnt > 0u ? cnt : 1u;
}
__device__ __forceinline__ void grid_bar(unsigned* bar, volatile LAS unsigned* st, int wv) {
    asm volatile("s_waitcnt vmcnt(0)" ::: "memory");
    __syncthreads();
    if (fresh_tid(wv) == 0) {
        __builtin_amdgcn_s_waitcnt(0);
        const unsigned x = xb_xcc_id();
        unsigned nloc = st[0], nx = st[1];
        if (nloc == 0u) { xcd_barrier_complete(bar, x, nloc, nx); st[0] = nloc; st[1] = nx; }
        const unsigned old = xb_add(&bar[XB_XSUB(x)], 1u);
        const unsigned gen = old / nloc;
        if (old + 1u == (gen + 1u) * nloc) {
            __builtin_amdgcn_fence(__ATOMIC_RELEASE, "agent");
            asm volatile("s_waitcnt vmcnt(0)" ::: "memory");
            const unsigned og = xb_add(&bar[XB_TOP], 1u);
            const unsigned tg = og / nx;
            if (og + 1u == (tg + 1u) * nx) xb_add(&bar[XB_TOPGEN], 1u);
            else XB_SPIN(xb_ld(&bar[XB_TOPGEN]) == tg, bar);
            __builtin_amdgcn_fence(__ATOMIC_ACQUIRE, "agent");
            xb_add(&bar[XB_XGEN(x)], 1u);
            asm volatile("s_waitcnt vmcnt(0)" ::: "memory");
        } else {
            XB_SPIN(xb_ld(&bar[XB_XGEN(x)]) == gen, bar);
            __builtin_amdgcn_fence(__ATOMIC_ACQUIRE, "agent");
            asm volatile("s_waitcnt vmcnt(0)" ::: "memory");
        }
    }
    __syncthreads();
}
#ifndef PROBE_SUB
#define PROBE_SUB 0x11111
#endif
__device__ __forceinline__ int opaque_sub(int k) { int n = (PROBE_SUB >> (4 * k)) & 15; asm volatile("" : "+s"(n)); return n; }
#define REPSUB(k) for (int rs_ = 0, nrs_ = opaque_sub(k); rs_ < nrs_; ++rs_)
#ifndef PROBE_REP
#define PROBE_REP 0x1111111
#endif
__device__ __forceinline__ int opaque_rep(int k) { int n = (PROBE_REP >> (4 * k)) & 15; asm volatile("" : "+s"(n)); return n; }
constexpr int LDS_BYTES = pg8::STAGE_BYTES + 4096 + 64;
static_assert(SHM_ATTN <= LDS_BYTES, "lds");
static_assert(9 * 1024 * 4 + 16 * 9 * 32 * 4 <= LDS_BYTES, "lds");

__global__ void __launch_bounds__(512, 2) fwd_megakernel(Params p) {
    extern __shared__ __attribute__((aligned(16))) unsigned char smem[];
    cg::grid_group grid = cg::this_grid();
    const int G = gridDim.x, bid = blockIdx.x;
    int wv = __builtin_amdgcn_readfirstlane(threadIdx.x >> 6); asm volatile("" : "+s"(wv));
    unsigned* bar_words = (unsigned*)(p.ws + WS_BAR); volatile LAS unsigned* bar_st = (volatile LAS unsigned*)((LAS unsigned char*)smem + pg8::STAGE_BYTES + 4096);
    if (fresh_tid(wv) == 0) { bar_st[0] = 0u; bar_st[1] = 0u; (void)xb_add(&bar_words[XB_XCNT(xb_xcc_id())], 1u); }
    if (G > (1 << 20)) grid.sync();
#define GBAR() grid_bar(bar_words, bar_st, wv)
    bf16_t* H = (bf16_t*)(p.ws + WS_H); bf16_t* U = (bf16_t*)(p.ws + WS_U); bf16_t* BR = (bf16_t*)(p.ws + WS_BR);
#define REPEAT(k) for (int rep_ = 0, nrep_ = opaque_rep(k); rep_ < nrep_; ++rep_)
    REPEAT(0) {
    if (bid < 96) phase_mod(p, (char*)smem, wv);
    phase_weights(p, (char*)smem, wv, 0, 0);
    GBAR(); }
    REPEAT(1) {
    phase_norm(p, wv);
    GBAR(); }
    REPEAT(2) {
    { pg8::Gemm g{H, (const bf16_t*)(p.ws + WS_WIN), 1024, 1024, 1024}; pg8::StaticOrder S; S.init(MT / 256, NINP / 256, G, bid);
      pg8::EpiU E{U, (float*)(p.ws + WS_SSQ), (float*)(p.ws + WS_SSKV), (float*)(p.ws + WS_SSKR)};
      pg8::gemm_phase(( LAS unsigned char*)smem, g, S, E, wv); }
    { const int nfive = (MT / 256) * (NINP / 256) - 4 * G;
      phase_weights(p, (char*)smem, wv, 1, (nfive > 0 && nfive < G) ? nfive : 0); }
    GBAR(); }
    REPEAT(3) {
    REPSUB(0)
    { pg8::Gemm g{U, (const bf16_t*)(p.ws + WS_WUQ), NINP, 256, 256}; pg8::StaticOrder S; S.init(ML / 256, 3, G, (bid + 128) % G); S.latent = 1;
      pg8::EpiStore E{(bf16_t*)(p.ws + WS_QRAW), 768};
      pg8::gemm_phase((LAS unsigned char*)smem, g, S, E, wv); }
    REPSUB(1)
    { pg8::Gemm g{U + OFF_CKV, (const bf16_t*)(p.ws + WS_WUKV), NINP, 128, 128}; pg8::StaticOrder S; S.init(MT / 256, 4, G, bid);
      pg8::EpiKV E{(char*)(p.ws + WS_KIMG), (bf16_t*)(p.ws + WS_V), U, (const float*)(p.ws + WS_SSKV), (const float*)(p.ws + WS_SSKR), p.k_norm_g, (const float*)(p.ws + WS_ROPE), (LAS float*)(smem + pg8::STAGE_BYTES)};
      pg8::gemm_phase((LAS unsigned char*)smem, g, S, E, wv); }
    REPSUB(2) { phase_pooled(p, wv); __syncthreads(); }
    GBAR(); }
    REPEAT(5) {
    { const int xcd = bid & 7, s = bid >> 3;
      if (G == 256) { for (int it = 0; it < 2; ++it) { const int grp = xcd * 4 + it * 2 + (s >> 4); __syncthreads(); attn_item(p, grp >> 2, grp & 3, s & 15, (char*)smem, wv); } }
      else { for (int item = bid; item < 512; item += G) { __syncthreads(); attn_item(p, item >> 6, (item >> 4) & 3, item & 15, (char*)smem, wv); } }
    }
    GBAR(); }
    REPEAT(6) {
    { pg8::Gemm g{BR, (const bf16_t*)(p.ws + WS_WOUT), 1024, 1024, 1024}; pg8::StaticOrder S; S.init(ML / 256, 4, G, bid);
      pg8::EpiOut E{p.out, p.x, (const float*)(p.ws + WS_MOD)};
      pg8::gemm_phase((LAS unsigned char*)smem, g, S, E, wv); }
    __syncthreads(); }
}

extern "C" void kernel_launch(void* const* d_in, const int* in_sizes, int n_in, void* d_out, int out_size, void* d_ws, size_t ws_size, hipStream_t stream) {
    static int grid_blocks = 0;
    if (grid_blocks == 0) {
        if (n_in != 17 || ws_size < WS_END) { fprintf(stderr, "kernel_launch: bad n_in %d or ws %zu < %zu\n", n_in, ws_size, (size_t)WS_END); grid_blocks = -1; return; }
        int dev = 0, cus = 0, per_cu = 0;
        hipGetDevice(&dev);
        hipDeviceGetAttribute(&cus, hipDeviceAttributeMultiprocessorCount, dev);
        if (hipFuncSetAttribute((const void*)fwd_megakernel, hipFuncAttributeMaxDynamicSharedMemorySize, LDS_BYTES) != hipSuccess) { fprintf(stderr, "hipFuncSetAttribute failed\n"); grid_blocks = -1; return; }
        if (hipOccupancyMaxActiveBlocksPerMultiprocessor(&per_cu, (const void*)fwd_megakernel, 512, LDS_BYTES) != hipSuccess || per_cu < 1) { fprintf(stderr, "occupancy query failed (%d)\n", per_cu); grid_blocks = -1; return; }
        grid_blocks = cus * per_cu;
    }
    if (grid_blocks < 0) return;
    Params p{};
    p.x = (const float*)d_in[0]; p.c = (const float*)d_in[1]; p.ctx = (const float*)d_in[2]; p.c_ctx = (const float*)d_in[3];
    p.w_mod = (const float*)d_in[4]; p.b_mod = (const float*)d_in[5]; p.norm_g = (const float*)d_in[6]; p.w_in = (const float*)d_in[7];
    p.q_lora_g = (const float*)d_in[8]; p.w_uq = (const float*)d_in[9]; p.kv_lora_g = (const float*)d_in[10]; p.w_ukv = (const float*)d_in[11];
    p.q_norm_g = (const float*)d_in[12]; p.k_norm_g = (const float*)d_in[13]; p.w_pool = (const float*)d_in[14]; p.pool_scale = (const float*)d_in[15];
    p.w_out = (const float*)d_in[16]; p.out = (float*)d_out; p.ws = (unsigned char*)d_ws;
    if (hipMemsetAsync((char*)d_ws + WS_BAR, 0, 16384, stream) != hipSuccess) { fprintf(stderr, "memset failed\n"); return; }
    void* args[] = {&p};
    hipError_t e = hipLaunchCooperativeKernel((const void*)fwd_megakernel, dim3(grid_blocks), dim3(512), args, LDS_BYTES, stream);
    if (e != hipSuccess) fprintf(stderr, "cooperative launch failed: %s (grid %d)\n", hipGetErrorString(e), grid_blocks);
}
```
